# Optimizing an MI355X kernel written in HIP

```python
import math
import jax
import jax.numpy as jnp
from jax import lax
import numpy as np

D_MODEL = 2048
BATCH = 4
SEQ = 8192
DEPTH = 1

A_HEADS = 8
A_QK_DIM = 64
A_V_DIM = 2 * A_QK_DIM
B_HEADS = 8
B_GROUPS = 2
B_HPG = B_HEADS // B_GROUPS
B_HEAD_DIM = 128
CMP_LEN = 32
CMP_STRIDE = 16
CMP_HIDDEN = 256
SLC_BLOCK = 64
SLC_TOPK = 16
WINDOW = 512
FORCE_SCORE = 1.0e4
ROPE_THETA = 500000.0
ROPE_FRACTION = 4
Q_BLOCK = 128
NSA_Q_BLOCK = 64
EPS = 1e-6
NEG = -1e30

A_Q_W = A_HEADS * 2 * A_QK_DIM
A_V_W = A_HEADS * A_V_DIM
B_Q_W = B_HEADS * B_HEAD_DIM
B_KV_W = B_GROUPS * B_HEAD_DIM
B_GATE_W = B_HEADS * 3
MERGE_W = 2 * D_MODEL
SPLIT_WIDTHS = (A_Q_W, A_Q_W, A_V_W, A_V_W,
                B_Q_W, B_KV_W, B_KV_W, B_KV_W, B_KV_W, B_KV_W, B_KV_W, B_Q_W, B_GATE_W,
                MERGE_W)
IN_WIDTH = sum(SPLIT_WIDTHS)
MIX_WIDTH = A_V_W + B_Q_W

kernel_name = "hybrid_diffattn_nsa_gated_block"


def rms_norm(x, g):
    xf = x.astype(jnp.float32)
    y = xf * lax.rsqrt(jnp.mean(xf * xf, axis=-1, keepdims=True) + EPS)
    return (y * g.astype(jnp.float32)).astype(x.dtype)


def rope_partial(x, pos):
    d = x.shape[-1]
    rd = d // ROPE_FRACTION
    half = rd // 2
    inv = 1.0 / (ROPE_THETA ** (jnp.arange(half, dtype=jnp.float32) * (2.0 / rd)))
    ang = pos.astype(jnp.float32)[:, None] * inv[None, :]
    cos = jnp.cos(ang)[:, None, :]
    sin = jnp.sin(ang)[:, None, :]
    x1 = x[..., :half].astype(jnp.float32)
    x2 = x[..., half:rd].astype(jnp.float32)
    rot = jnp.concatenate([x1 * cos - x2 * sin, x2 * cos + x1 * sin], axis=-1).astype(x.dtype)
    return jnp.concatenate([rot, x[..., rd:]], axis=-1)


def masked_softmax(s, mask):
    s = jnp.where(mask, s.astype(jnp.float32), NEG)
    p = jax.nn.softmax(s, axis=-1)
    return jnp.where(mask, p, 0.0)


def split_cols(p):
    outs = []
    off = 0
    for w in SPLIT_WIDTHS:
        outs.append(p[..., off:off + w])
        off += w
    return outs


def diff_attention(q, k, v, lam, lam_init, sub_g):
    B, S, H, _, dqk = q.shape
    dv = v.shape[-1]
    scale = dqk ** -0.5
    kpos = jnp.arange(S)

    def block(i):
        s0 = i * Q_BLOCK
        qb = lax.dynamic_slice_in_dim(q, s0, Q_BLOCK, axis=1)
        s = jnp.einsum('bqhmd,bkhmd->bhmqk', qb, k).astype(jnp.float32) * scale
        qpos = s0 + jnp.arange(Q_BLOCK)
        mask = kpos[None, :] <= qpos[:, None]
        p = jax.nn.softmax(jnp.where(mask, s, NEG), axis=-1)
        a = p[:, :, 0] - lam * p[:, :, 1]
        return jnp.einsum('bhqk,bkhd->bqhd', a.astype(v.dtype), v)

    o = lax.map(block, jnp.arange(S // Q_BLOCK))
    o = o.transpose(1, 0, 2, 3, 4).reshape(B, S, H, dv)
    return rms_norm(o, sub_g) * (1.0 - lam_init)


def compress_blocks(x, pe, w1, w2):
    B, S, G, d = x.shape
    n_cmp = (S - CMP_LEN) // CMP_STRIDE + 1
    idx = jnp.arange(n_cmp)[:, None] * CMP_STRIDE + jnp.arange(CMP_LEN)[None, :]
    blk = x[:, idx] + pe[None, None, :, None, :]
    flat = blk.transpose(0, 1, 3, 2, 4).reshape(B, n_cmp, G, CMP_LEN * d)
    return jax.nn.silu(flat @ w1) @ w2


def nsa_attention(q, kc_raw, vc_raw, ks, vs, kw, vw, gates, pe_k, pe_v, w1k, w2k, w1v, w2v):
    B, S, H, d = q.shape
    G = B_GROUPS
    scale = d ** -0.5
    dt = q.dtype
    n_cmp = (S - CMP_LEN) // CMP_STRIDE + 1
    cmp_start = jnp.arange(n_cmp) * CMP_STRIDE
    cmp_end = cmp_start + CMP_LEN - 1
    kc = rope_partial(compress_blocks(kc_raw, pe_k, w1k, w2k), cmp_end)
    vc = compress_blocks(vc_raw, pe_v, w1v, w2v)
    n_slc = S // SLC_BLOCK
    n_top = min(SLC_TOPK, n_slc)
    ks_blk = ks.reshape(B, n_slc, SLC_BLOCK, G, d).transpose(0, 3, 1, 2, 4)
    vs_blk = vs.reshape(B, n_slc, SLC_BLOCK, G, d).transpose(0, 3, 1, 2, 4)
    slc_start = jnp.arange(n_slc) * SLC_BLOCK
    overlap = ((cmp_start[:, None] < slc_start[None, :] + SLC_BLOCK) &
               (cmp_start[:, None] + CMP_LEN > slc_start[None, :])).astype(jnp.float32)
    jb = jnp.arange(n_slc)
    b_ix = jnp.arange(B)[:, None, None, None]
    g_ix = jnp.arange(G)[None, :, None, None]
    kw_pad = jnp.pad(kw, ((0, 0), (WINDOW, 0), (0, 0), (0, 0)))
    vw_pad = jnp.pad(vw, ((0, 0), (WINDOW, 0), (0, 0), (0, 0)))
    qg = q.reshape(B, S, G, B_HPG, d)
    gg = gates.reshape(B, S, G, B_HPG, 3)
    QB = NSA_Q_BLOCK

    def block(i):
        s0 = i * QB
        qpos = s0 + jnp.arange(QB)
        qb = lax.dynamic_slice_in_dim(qg, s0, QB, axis=1)
        sc = jnp.einsum('bqghd,bcgd->bghqc', qb, kc) * scale
        pc = masked_softmax(sc, cmp_end[None, :] <= qpos[:, None])
        o_cmp = jnp.einsum('bghqc,bcgd->bqghd', pc.astype(dt), vc)
        imp = jnp.einsum('bghqc,cn->bgqn', pc, overlap)
        cur = qpos // SLC_BLOCK
        forced = (jb[None, :] == 0) | (jb[None, :] == cur[:, None]) | (jb[None, :] == cur[:, None] - 1)
        valid = slc_start[None, :] <= qpos[:, None]
        imp = jnp.where(forced & valid, FORCE_SCORE, imp)
        imp = jnp.where(valid, imp, NEG)
        top_val, top_idx = lax.top_k(imp, n_top)
        sel_ok = top_val > NEG * 0.5
        kg = ks_blk[b_ix, g_ix, top_idx]
        vg = vs_blk[b_ix, g_ix, top_idx].reshape(B, G, QB, n_top * SLC_BLOCK, d)
        ss = jnp.einsum('bqghd,bgqnkd->bghqnk', qb, kg) * scale
        ss = ss.reshape(B, G, B_HPG, QB, n_top * SLC_BLOCK)
        kpos = top_idx[..., None] * SLC_BLOCK + jnp.arange(SLC_BLOCK)
        smask = (kpos <= qpos[None, None, :, None, None]) & sel_ok[..., None]
        ps = masked_softmax(ss, smask.reshape(B, G, 1, QB, n_top * SLC_BLOCK))
        o_slc = jnp.einsum('bghqk,bgqkd->bqghd', ps.astype(dt), vg)
        kwb = lax.dynamic_slice_in_dim(kw_pad, s0, QB + WINDOW, axis=1)
        vwb = lax.dynamic_slice_in_dim(vw_pad, s0, QB + WINDOW, axis=1)
        wpos = s0 - WINDOW + jnp.arange(QB + WINDOW)
        wmask = ((wpos[None, :] <= qpos[:, None]) & (wpos[None, :] > qpos[:, None] - WINDOW)
                 & (wpos[None, :] >= 0))
        sw = jnp.einsum('bqghd,bkgd->bghqk', qb, kwb) * scale
        pw = masked_softmax(sw, wmask)
        o_win = jnp.einsum('bghqk,bkgd->bqghd', pw.astype(dt), vwb)
        gb = lax.dynamic_slice_in_dim(gg, s0, QB, axis=1)
        return gb[..., 0:1] * o_cmp + gb[..., 1:2] * o_slc + gb[..., 2:3] * o_win

    o = lax.map(block, jnp.arange(S // QB))
    return o.transpose(1, 0, 2, 3, 4, 5).reshape(B, S, H, d)


def setup_inputs(seed: int = 0) -> dict:
    key = jax.random.key(seed)
    ks = jax.random.split(key, 22)
    L, D = DEPTH, D_MODEL

    def nrm(k, shape, scale):
        return jax.random.normal(k, shape, jnp.float32) * scale

    return {
        "x": nrm(ks[0], (BATCH, SEQ, D), 1.0),
        "c": nrm(ks[1], (BATCH, D), 1.0),
        "w_ada": nrm(ks[2], (L, D, 3 * D), 0.3 * D ** -0.5),
        "b_ada": nrm(ks[3], (L, 3 * D), 0.01),
        "norm_g": 1.0 + nrm(ks[4], (L, D), 0.02),
        "w_in": nrm(ks[5], (L, D, IN_WIDTH), D ** -0.5),
        "lambda_q1": nrm(ks[6], (L, A_QK_DIM), 0.1),
        "lambda_k1": nrm(ks[7], (L, A_QK_DIM), 0.1),
        "lambda_q2": nrm(ks[8], (L, A_QK_DIM), 0.1),
        "lambda_k2": nrm(ks[9], (L, A_QK_DIM), 0.1),
        "diff_norm_g": 1.0 + nrm(ks[10], (L, A_V_DIM), 0.02),
        "cmp_pe_k": nrm(ks[11], (L, CMP_LEN, B_HEAD_DIM), 0.1),
        "cmp_pe_v": nrm(ks[12], (L, CMP_LEN, B_HEAD_DIM), 0.1),
        "cmp_w1_k": nrm(ks[13], (L, CMP_LEN * B_HEAD_DIM, CMP_HIDDEN), (CMP_LEN * B_HEAD_DIM) ** -0.5),
        "cmp_w2_k": nrm(ks[14], (L, CMP_HIDDEN, B_HEAD_DIM), CMP_HIDDEN ** -0.5),
        "cmp_w1_v": nrm(ks[15], (L, CMP_LEN * B_HEAD_DIM, CMP_HIDDEN), (CMP_LEN * B_HEAD_DIM) ** -0.5),
        "cmp_w2_v": nrm(ks[16], (L, CMP_HIDDEN, B_HEAD_DIM), CMP_HIDDEN ** -0.5),
        "w_branch": nrm(ks[17], (L, MIX_WIDTH, D), A_V_W ** -0.5),
        "w_out": nrm(ks[18], (L, D, D), D ** -0.5),
        "final_norm_g": 1.0 + nrm(ks[19], (D,), 0.02),
    }


def reference(x, c, w_ada, b_ada, norm_g, w_in, lambda_q1, lambda_k1, lambda_q2, lambda_k2,
              diff_norm_g, cmp_pe_k, cmp_pe_v, cmp_w1_k, cmp_w2_k, cmp_w1_v, cmp_w2_v,
              w_branch, w_out, final_norm_g):
    B, S, D = x.shape
    pos = jnp.arange(S)
    for l in range(DEPTH):
        mod = jax.nn.silu(c) @ w_ada[l] + b_ada[l]
        shift, scale, gate = jnp.split(mod, 3, axis=-1)
        h = rms_norm(x, norm_g[l]) * (1.0 + scale[:, None, :]) + shift[:, None, :]
        (aq, ak, av, az, bq, bkc, bvc, bks, bvs, bkw, bvw, bz, bgate, mgate) = split_cols(h @ w_in[l])
        aq = rope_partial(aq.reshape(B, S, A_HEADS * 2, A_QK_DIM), pos).reshape(B, S, A_HEADS, 2, A_QK_DIM)
        ak = rope_partial(ak.reshape(B, S, A_HEADS * 2, A_QK_DIM), pos).reshape(B, S, A_HEADS, 2, A_QK_DIM)
        av = av.reshape(B, S, A_HEADS, A_V_DIM)
        lam_init = 0.8 - 0.6 * math.exp(-0.3 * l)
        lam = (jnp.exp(jnp.sum(lambda_q1[l].astype(jnp.float32) * lambda_k1[l].astype(jnp.float32)))
               - jnp.exp(jnp.sum(lambda_q2[l].astype(jnp.float32) * lambda_k2[l].astype(jnp.float32)))
               + lam_init)
        oa = diff_attention(aq, ak, av, lam, lam_init, diff_norm_g[l])
        ya = (oa.reshape(B, S, A_V_W) * jax.nn.silu(az)) @ w_branch[l, :A_V_W]
        bq = rope_partial(bq.reshape(B, S, B_HEADS, B_HEAD_DIM), pos)
        kv_shape = (B, S, B_GROUPS, B_HEAD_DIM)
        bks = rope_partial(bks.reshape(kv_shape), pos)
        bkw = rope_partial(bkw.reshape(kv_shape), pos)
        bg = jax.nn.sigmoid(bgate).reshape(B, S, B_HEADS, 3)
        ob = nsa_attention(bq, bkc.reshape(kv_shape), bvc.reshape(kv_shape), bks, bvs.reshape(kv_shape),
                           bkw, bvw.reshape(kv_shape), bg, cmp_pe_k[l], cmp_pe_v[l],
                           cmp_w1_k[l], cmp_w2_k[l], cmp_w1_v[l], cmp_w2_v[l])
        yb = (ob.reshape(B, S, B_Q_W) * jax.nn.silu(bz)) @ w_branch[l, A_V_W:]
        ga, gb = jnp.split(jax.nn.sigmoid(mgate), 2, axis=-1)
        y = (ga * ya + gb * yb) @ w_out[l]
        x = x + gate[:, None, :] * y
    return rms_norm(x, final_norm_g)
```

```cpp
#include <hip/hip_runtime.h>
#include <hip/hip_cooperative_groups.h>
#include <stdint.h>
#include <stdio.h>
namespace cg = cooperative_groups;

#ifndef MULTI
#define MULTI 0
#endif

#define DI static __device__ __forceinline__
typedef unsigned short u16;
typedef __attribute__((ext_vector_type(8))) short bf16x8;
typedef __attribute__((ext_vector_type(4))) float f32x4;
typedef __attribute__((ext_vector_type(4))) unsigned u32x4;

constexpr int NTHR = 512;
constexpr int DM = 2048, NB = 4, SQ = 8192, TT = NB * SQ;
constexpr int NWP = 12032;
constexpr int SMEM_BYTES = 149504;
constexpr float LOG2E = 1.4426950408889634f;
constexpr float EPSN = 1e-6f;

struct Params {
  const float *x, *c, *w_ada, *b_ada, *norm_g, *w_in, *lq1, *lk1, *lq2, *lk2, *diff_g, *pe_k, *pe_v,
      *w1k, *w2k, *w1v, *w2v, *w_branch, *w_out, *fin_g;
  float* out;
  u16 *WtIn, *WbT, *WoT, *W1T, *W2T, *H, *Qa, *Ka, *VaT, *Za, *Qb, *KcR, *VcR, *Ks, *VsT, *Kw, *VwT, *Zb, *Mg,
      *Hc, *Kc, *VcT, *Merged;
  float *Bg, *mod, *cvec;
  float2 *tabA, *tabB;
  int* ctr;
};

typedef __attribute__((ext_vector_type(2))) float f32x2;
typedef __attribute__((ext_vector_type(2))) __bf16 bf16x2_t;
DI unsigned pk2(float a, float b) { f32x2 v = {a, b}; bf16x2_t r = __builtin_convertvector(v, bf16x2_t); return __builtin_bit_cast(unsigned, r); }
DI u16 f2bf(float x) { return (u16)(pk2(x, 0.f) & 0xffffu); }
DI float bflo(unsigned w) { return __uint_as_float(w << 16); }
DI float bfhi(unsigned w) { return __uint_as_float(w & 0xffff0000u); }
DI float ex2(float x) { return __builtin_amdgcn_exp2f(x); }
DI float silu_f(float x) { return x * __builtin_amdgcn_rcpf(1.f + ex2(-LOG2E * x)); }
DI float sigm_f(float x) { return __builtin_amdgcn_rcpf(1.f + ex2(-LOG2E * x)); }
DI f32x4 mfma16(bf16x8 a, bf16x8 b, f32x4 c) { return __builtin_amdgcn_mfma_f32_16x16x32_bf16(a, b, c, 0, 0, 0); }
DI bf16x8 mk8(unsigned a, unsigned b, unsigned c, unsigned d) { u32x4 v = {a, b, c, d}; return __builtin_bit_cast(bf16x8, v); }
DI float wave_sum(float v) {
#pragma unroll
  for (int o = 32; o > 0; o >>= 1) v += __shfl_xor(v, o);
  return v;
}
DI float rowmax4(float x) {
  unsigned u = __float_as_uint(x);
  auto r = __builtin_amdgcn_permlane16_swap(u, u, false, false);
  x = fmaxf(__uint_as_float(r[0]), __uint_as_float(r[1]));
  u = __float_as_uint(x);
  auto q = __builtin_amdgcn_permlane32_swap(u, u, false, false);
  return fmaxf(__uint_as_float(q[0]), __uint_as_float(q[1]));
}
DI f32x4 zero4() { f32x4 z = {0.f, 0.f, 0.f, 0.f}; return z; }

template <class KO>
DI void gemm_main(f32x4 (&acc)[4][4], const u16* (&ap)[4], KO koff, const u16* (&bp)[2], int nk, char* smem, int tid) {
  const int lane = tid & 63, wid = tid >> 6, wm = wid >> 1, wn = wid & 1;
  const int lr = lane & 15, quad = lane >> 4;
  const int c = tid & 7, r = tid >> 3;
  const int woff = r * 128 + ((c ^ (r & 7)) << 4);
  char* As = smem;
  char* Bs = smem + 65536;
  uint4 ra[4], rb[2];
  __syncthreads();
  {
    long ko = koff(0);
#pragma unroll
    for (int i = 0; i < 4; ++i) ra[i] = *(const uint4*)(ap[i] + ko);
#pragma unroll
    for (int i = 0; i < 2; ++i) rb[i] = *(const uint4*)(bp[i]);
#pragma unroll
    for (int i = 0; i < 4; ++i) *(uint4*)(As + woff + i * 8192) = ra[i];
#pragma unroll
    for (int i = 0; i < 2; ++i) *(uint4*)(Bs + woff + i * 8192) = rb[i];
  }
  __syncthreads();
  for (int kt = 0; kt < nk; ++kt) {
    const int cur = kt & 1;
    if (kt + 1 < nk) {
      long ko = koff(kt + 1);
#pragma unroll
      for (int i = 0; i < 4; ++i) ra[i] = *(const uint4*)(ap[i] + ko);
#pragma unroll
      for (int i = 0; i < 2; ++i) rb[i] = *(const uint4*)(bp[i] + (size_t)(kt + 1) * 64);
    }
    const char* Ab = As + cur * 32768 + (wm * 64 + lr) * 128;
    const char* Bb = Bs + cur * 16384 + (wn * 64 + lr) * 128;
#pragma unroll
    for (int kk = 0; kk < 2; ++kk) {
      const int sw = ((kk * 4 + quad) ^ (lr & 7)) << 4;
      bf16x8 af[4], bfr[4];
#pragma unroll
      for (int mt = 0; mt < 4; ++mt) af[mt] = *(const bf16x8*)(Ab + mt * 2048 + sw);
#pragma unroll
      for (int nt = 0; nt < 4; ++nt) bfr[nt] = *(const bf16x8*)(Bb + nt * 2048 + sw);
#pragma unroll
      for (int mt = 0; mt < 4; ++mt)
#pragma unroll
        for (int nt = 0; nt < 4; ++nt) acc[mt][nt] = mfma16(af[mt], bfr[nt], acc[mt][nt]);
    }
    if (kt + 1 < nk) {
      const int nx = cur ^ 1;
#pragma unroll
      for (int i = 0; i < 4; ++i) *(uint4*)(As + nx * 32768 + woff + i * 8192) = ra[i];
#pragma unroll
      for (int i = 0; i < 2; ++i) *(uint4*)(Bs + nx * 16384 + woff + i * 8192) = rb[i];
    }
    __syncthreads();
  }
}

DI bool tile_map(int it, int nbm, int nbn, int& tm, int& tn, bool& valid) {
  const int xcd = blockIdx.x & 7, local = blockIdx.x >> 3, per = gridDim.x >> 3;
  const int SN = per >> 3;
  const int nsn = (nbn + SN - 1) / SN, nsm = nbm >> 3;
  const int st = it * 8 + xcd;
  if (st >= nsm * nsn) return false;
  const int sm_ = st / nsn, sn_ = st - sm_ * nsn;
  tm = sm_ * 8 + (local & 7);
  tn = sn_ * SN + (local >> 3);
  valid = tn < nbn;
  return true;
}

template <class FN>
DI void epi_pairs(const f32x4 (&acc)[4][4], int row0, int col0, int lane, FN fn) {
  const int lr = lane & 15, quad = lane >> 4;
  const bool odd = lane & 1;
#pragma unroll
  for (int mt = 0; mt < 4; ++mt)
#pragma unroll
    for (int nt = 0; nt < 4; ++nt) {
      f32x4 v = acc[mt][nt];
      float s0 = odd ? v[0] : v[1], s1 = odd ? v[2] : v[3];
      float r0 = __shfl_xor(s0, 1), r1 = __shfl_xor(s1, 1);
      float a0 = odd ? r0 : v[0], a1 = odd ? v[1] : r0;
      float b0 = odd ? r1 : v[2], b1 = odd ? v[3] : r1;
      int rr = row0 + mt * 16 + quad * 4 + (odd ? 1 : 0);
      int cc = col0 + nt * 16 + (lr & ~1);
      fn(rr, cc, a0, a1);
      fn(rr + 2, cc, b0, b1);
    }
}
DI void store_rm(const f32x4 (&acc)[4][4], u16* dst, int ld, int row0, int col0, int lane) {
  epi_pairs(acc, row0, col0, lane, [&](int rr, int cc, float x, float y) __attribute__((always_inline)) {
    *(unsigned*)(dst + (size_t)rr * ld + cc) = pk2(x, y);
  });
}
DI void store_tr(const f32x4 (&acc)[4][4], u16* dstT, int row0  , int lane) {
  const int lr = lane & 15, quad = lane >> 4;
#pragma unroll
  for (int mt = 0; mt < 4; ++mt)
#pragma unroll
    for (int nt = 0; nt < 4; ++nt) {
      f32x4 v = acc[mt][nt];
      uint2 w = {pk2(v[0], v[1]), pk2(v[2], v[3])};
      *(uint2*)(dstT + (size_t)(nt * 16 + lr) * SQ + row0 + mt * 16 + quad * 4) = w;
    }
}

DI void transpose_item(const float* src, int ldsrc, int nsrc0, int nvalid, int k0, u16* dst, int lddst, int n0,
                       char* smem, int tid) {
  float* tile = (float*)smem;
  __syncthreads();
#pragma unroll
  for (int i = 0; i < 2; ++i) {
    int id = tid + NTHR * i, k = id >> 4, c4 = id & 15;
    float4 v = make_float4(0.f, 0.f, 0.f, 0.f);
    if (c4 * 4 < nvalid) v = *(const float4*)(src + (size_t)(k0 + k) * ldsrc + nsrc0 + c4 * 4);
    float* t = tile + k * 65 + c4 * 4;
    t[0] = v.x; t[1] = v.y; t[2] = v.z; t[3] = v.w;
  }
  __syncthreads();
  {
    int n = tid >> 3, kc = tid & 7;
    const float* t = tile + (kc * 8) * 65 + n;
    uint4 w;
    w.x = pk2(t[0], t[65]); w.y = pk2(t[130], t[195]); w.z = pk2(t[260], t[325]); w.w = pk2(t[390], t[455]);
    *(uint4*)(dst + (size_t)(n0 + n) * lddst + k0 + kc * 8) = w;
  }
}

DI void phase_prep(const Params& p, char* smem, int tid) {
  constexpr int N_WIN = 32 * 188, N_WB = 1024, N_WO = 1024, N_W1 = 256, N_W2 = 8;
  constexpr int O_WB = N_WIN, O_WO = O_WB + N_WB, O_W1K = O_WO + N_WO, O_W1V = O_W1K + N_W1, O_W2K = O_W1V + N_W1,
                O_W2V = O_W2K + N_W2, O_MOD = O_W2V + N_W2, O_CV = O_MOD + 96, O_TAB = O_CV + 8, O_END = O_TAB + 32;
  for (int it = blockIdx.x; it < O_END; it += gridDim.x) {
    if (it < O_WB) {
      int kt = it & 31, nt = it >> 5, n0 = nt * 64, src0, nv;
      if (n0 < 7680) { src0 = n0; nv = 64; }
      else if (n0 < 11776) { src0 = n0 + 24; nv = 64; }
      else if (n0 == 11776) { src0 = 7680; nv = 24; }
      else { src0 = 0; nv = 0; }
      transpose_item(p.w_in, 11800, src0, nv, kt * 64, p.WtIn, DM, n0, smem, tid);
    } else if (it < O_WO) {
      int i = it - O_WB; transpose_item(p.w_branch, DM, (i >> 5) * 64, 64, (i & 31) * 64, p.WbT, DM, (i >> 5) * 64, smem, tid);
    } else if (it < O_W1K) {
      int i = it - O_WO; transpose_item(p.w_out, DM, (i >> 5) * 64, 64, (i & 31) * 64, p.WoT, DM, (i >> 5) * 64, smem, tid);
    } else if (it < O_W2K) {
      int i = it - O_W1K; int kv = i >> 8; i &= 255;
      transpose_item(kv ? p.w1v : p.w1k, 256, (i >> 6) * 64, 64, (i & 63) * 64, p.W1T + (size_t)kv * 256 * 4096, 4096, (i >> 6) * 64, smem, tid);
    } else if (it < O_MOD) {
      int i = it - O_W2K; int kv = i >> 3; i &= 7;
      transpose_item(kv ? p.w2v : p.w2k, 128, (i >> 2) * 64, 64, (i & 3) * 64, p.W2T + (size_t)kv * 128 * 256, 256, (i >> 2) * 64, smem, tid);
    } else if (it < O_CV) {
      int col0 = (it - O_MOD) * 64;
      float* sc = (float*)smem;
      float* red = (float*)(smem + 32768);
      __syncthreads();
      for (int i = tid; i < NB * DM; i += NTHR) sc[i] = silu_f(p.c[i]);
      __syncthreads();
      int col = tid & 63, kg = tid >> 6;
      float a0 = 0, a1 = 0, a2 = 0, a3 = 0;
      for (int k = kg * 256; k < kg * 256 + 256; ++k) {
        float w = p.w_ada[(size_t)k * 6144 + col0 + col];
        a0 += sc[k] * w; a1 += sc[DM + k] * w; a2 += sc[2 * DM + k] * w; a3 += sc[3 * DM + k] * w;
      }
      red[(kg * 4 + 0) * 64 + col] = a0; red[(kg * 4 + 1) * 64 + col] = a1;
      red[(kg * 4 + 2) * 64 + col] = a2; red[(kg * 4 + 3) * 64 + col] = a3;
      __syncthreads();
      if (tid < 256) {
        int b = tid >> 6, cc = tid & 63; float s = 0;
#pragma unroll
        for (int g = 0; g < 8; ++g) s += red[(g * 4 + b) * 64 + cc];
        p.mod[b * 6144 + col0 + cc] = s + p.b_ada[col0 + cc];
      }
    } else if (it < O_TAB) {
      int i = it - O_CV, kv = i >> 2, col0 = (i & 3) * 64;
      const float* pe = kv ? p.pe_v : p.pe_k; const float* w1 = kv ? p.w1v : p.w1k;
      float* red = (float*)smem;
      __syncthreads();
      int col = tid & 63, kg = tid >> 6; float a = 0;
      for (int k = kg * 512; k < kg * 512 + 512; ++k) a += pe[k] * w1[(size_t)k * 256 + col0 + col];
      red[kg * 64 + col] = a;
      __syncthreads();
      if (tid < 64) { float s = 0;
#pragma unroll
        for (int g = 0; g < 8; ++g) s += red[g * 64 + tid];
        p.cvec[kv * 256 + col0 + tid] = s; }
    } else {
      int i = it - O_TAB;
      if (i == 0 && tid == 0) { p.ctr[0] = 0; p.ctr[1] = 0; }
      if (tid < 256) {
        int pos = i * 256 + tid;
        for (int fi = 0; fi < 24; ++fi) {
          double ex = (fi < 16) ? (double)fi * (2.0 / 32.0) : (double)(fi - 16) * (2.0 / 16.0);
          float inv = (float)(1.0 / exp2(ex * 18.931568569324174));
          float ang = (float)pos * inv;
          double rev = (double)ang * 0.15915494309189535;
          rev -= rint(rev);
          float fr = (float)rev;
          float2 cs = make_float2(__builtin_amdgcn_cosf(fr), __builtin_amdgcn_sinf(fr));
          if (fi < 16) p.tabB[pos * 16 + fi] = cs; else p.tabA[pos * 8 + (fi - 16)] = cs;
        }
      }
      if (i == 1) {
        for (int e = tid; e < 8 * 128; e += NTHR) {
          int bg = e >> 7, d = e & 127;
          p.Kc[((size_t)bg * 512 + 511) * 128 + d] = 0;
          p.VcT[((size_t)bg * 128 + d) * 512 + 511] = 0;
        }
      }
    }
  }
}

DI void phase_h(const Params& p, int tid) {
  const int lane = tid & 63, wid = tid >> 6;
  for (int it = blockIdx.x; it < TT / 16; it += gridDim.x) {
#pragma unroll 1
    for (int rr = 0; rr < 2; ++rr) {
      int row = it * 16 + wid * 2 + rr, b = row >> 13;
      const float4* xr = (const float4*)(p.x + (size_t)row * DM);
      float4 v[8]; float ss = 0;
#pragma unroll
      for (int i = 0; i < 8; ++i) { v[i] = xr[lane + 64 * i]; ss += v[i].x * v[i].x + v[i].y * v[i].y + v[i].z * v[i].z + v[i].w * v[i].w; }
      ss = wave_sum(ss);
      float rs = rsqrtf(ss * (1.f / DM) + EPSN);
      const float4* g4 = (const float4*)p.norm_g;
      const float4* sh4 = (const float4*)(p.mod + b * 6144);
      const float4* sc4 = (const float4*)(p.mod + b * 6144 + DM);
#pragma unroll
      for (int i = 0; i < 8; ++i) {
        int c4 = lane + 64 * i; float4 g = g4[c4], sh = sh4[c4], sc = sc4[c4];
        float o0 = v[i].x * rs * g.x * (1.f + sc.x) + sh.x, o1 = v[i].y * rs * g.y * (1.f + sc.y) + sh.y;
        float o2 = v[i].z * rs * g.z * (1.f + sc.z) + sh.z, o3 = v[i].w * rs * g.w * (1.f + sc.w) + sh.w;
        uint2 w = {pk2(o0, o1), pk2(o2, o3)};
        *(uint2*)(p.H + (size_t)row * DM + c4 * 4) = w;
      }
    }
  }
}

namespace g8 {
#define G8_LAS __attribute__((address_space(3)))
constexpr int BK = 64, HALF = 128, HTB = HALF * BK * 2;
DI int lds_byte(int r, int c) { const int st = (r >> 4) * 2 + (c >> 5), rr = r & 15, cc = c & 31, ob = rr * 64 + cc * 2; return st * 1024 + (ob ^ (((ob >> 9) & 1) << 5)); }
DI void stage_rc(int b, int& R, int& C) { const int st = b / 1024, sb = b % 1024, swz = sb ^ (((sb >> 9) & 1) << 5); R = (st >> 1) * 16 + swz / 64; C = (st & 1) * 32 + (swz % 64) / 2; }
DI int perm32(int rho) { const int n = rho >> 4, i = rho & 15; return 8 * (i >> 2) + 4 * n + (i & 3); }
struct Unit { const char* a; const char* b; int pm, pn, kind; };
DI bool order_next(int i, int G, int c, int nM, int nN, int& pm, int& pn) {
  const int nwg = nM * nN;
  const long L = (long)i * G + c; if (L >= nwg) return false;
  int wgid = (int)L; { const int q = nwg / 8, r = nwg % 8, xcd = wgid % 8, off = wgid / 8; wgid = (xcd < r ? xcd * (q + 1) : r * (q + 1) + (xcd - r) * q) + off; }
  const int nig = 8 * nN, gid = wgid / nig, fm = gid * 8, gsz = (nM - fm) < 8 ? (nM - fm) : 8;
  pm = fm + ((wgid % nig) % gsz); pn = (wgid % nig) / gsz; return true;
}

template <int LD, class Sched, class Epi>
DI void gemm_phase(G8_LAS unsigned char* lds, const int K, const Sched& S, const Epi& E) {
  const int tid = threadIdx.x, wid = __builtin_amdgcn_readfirstlane(tid >> 6), lane = tid & 63, wr = wid >> 2, wc = wid & 3, fr = lane & 15, fq = lane >> 4;
  const int nt = K / BK;
  unsigned voffA[2], voffB[2];
#pragma unroll
  for (int i = 0; i < 2; ++i) { int R, C; stage_rc(tid * 16 + i * 8192, R, C); const int Rb = (R & ~31) + perm32(R & 31);
    voffA[i] = (unsigned)(R * LD + C) * 2u; voffB[i] = (unsigned)(Rb * LD + C) * 2u; }
  const size_t kstep = (size_t)(BK * 2);
  const size_t hstep = (size_t)HALF * LD * 2;
  const unsigned ldsw = (unsigned)wid * 1024u;
  const int aoff = lds_byte(wr * 64 + fr, fq * 8), boff = lds_byte(wc * 32 + fr, fq * 8);
#define G8_SA(b, h) (((b) * 2 + (h)) * HTB)
#define G8_SB(b, h) ((4 + (b) * 2 + (h)) * HTB)
#define G8_STAGE(bufoff, gbase, voff) do { _Pragma("unroll") for (int _i = 0; _i < 2; ++_i) \
    __builtin_amdgcn_global_load_lds((const unsigned*)((const char*)(gbase) + (voff)[_i]), (G8_LAS unsigned*)(lds + (bufoff) + ldsw + _i * 8192), 16, 0, 0); } while (0)
#define G8_LDA(dst, b, h) do { _Pragma("unroll") for (int m = 0; m < 4; ++m) _Pragma("unroll") for (int k = 0; k < 2; ++k) dst[m][k] = *(const G8_LAS bf16x8*)(lds + G8_SA(b, h) + aoff + m * 2048 + k * 1024); } while (0)
#define G8_LDB(dst, b, h) do { _Pragma("unroll") for (int n = 0; n < 2; ++n) _Pragma("unroll") for (int k = 0; k < 2; ++k) dst[n][k] = *(const G8_LAS bf16x8*)(lds + G8_SB(b, h) + boff + n * 2048 + k * 1024); } while (0)
#define G8_MMA(ai, bj, At, Bt) do { __builtin_amdgcn_s_setprio(1); _Pragma("unroll") for (int m = 0; m < 4; ++m) _Pragma("unroll") for (int n = 0; n < 2; ++n) _Pragma("unroll") for (int k = 0; k < 2; ++k) \
    acc[ai][bj][m][n] = __builtin_amdgcn_mfma_f32_16x16x32_bf16(Bt[n][k], At[m][k], acc[ai][bj][m][n], 0, 0, 0); __builtin_amdgcn_s_setprio(0); } while (0)
#define G8_WAIT_V(n) asm volatile("s_waitcnt vmcnt(" #n ")" ::: "memory")
#define G8_WAIT_L(n) asm volatile("s_waitcnt lgkmcnt(" #n ")" ::: "memory")
#define G8_BAR __builtin_amdgcn_s_barrier()
#define G8_SCHED __builtin_amdgcn_sched_barrier(0)
  Unit cur, nxt; int ui = 0;
  if (!S.next(0, cur)) return;
  f32x4 acc[2][2][4][2];
#pragma unroll
  for (int a = 0; a < 2; ++a)
#pragma unroll
    for (int b = 0; b < 2; ++b)
#pragma unroll
      for (int m = 0; m < 4; ++m)
#pragma unroll
        for (int n = 0; n < 2; ++n) acc[a][b][m][n] = zero4();
  bf16x8 At[4][2], B0[2][2], B1[2][2];
  const char* cA = cur.a; const char* cB = cur.b;
  G8_STAGE(G8_SB(0, 0), cB, voffB); G8_STAGE(G8_SA(0, 0), cA, voffA); G8_STAGE(G8_SB(0, 1), cB + hstep, voffB); G8_STAGE(G8_SA(0, 1), cA + hstep, voffA);
  if (wr == 1) G8_BAR;
  G8_WAIT_V(4); G8_BAR;
  G8_STAGE(G8_SB(1, 0), cB + kstep, voffB); G8_STAGE(G8_SA(1, 0), cA + kstep, voffA); G8_STAGE(G8_SB(1, 1), cB + hstep + kstep, voffB);
  G8_WAIT_V(6); G8_BAR;
  for (;;) {
    const bool has_next = S.next(ui + 1, nxt);
    const char* nA = has_next ? nxt.a : cA; const char* nB = has_next ? nxt.b : cB;
    for (int t = 0; t < nt; t += 2) {
      const bool last = (t == nt - 2);
      const char* a1 = cA + (size_t)(t + 1) * kstep;
      const char* a2 = last ? nA : cA + (size_t)(t + 2) * kstep; const char* b2 = last ? nB : cB + (size_t)(t + 2) * kstep;
      const char* a3 = a2 + kstep; const char* b3 = b2 + kstep;
      G8_LDB(B0, 0, 0); G8_SCHED; G8_LDA(At, 0, 0); G8_STAGE(G8_SA(1, 1), a1 + hstep, voffA);
      G8_WAIT_L(8); G8_BAR; G8_WAIT_L(0); G8_MMA(0, 0, At, B0); G8_BAR; G8_SCHED;
      G8_LDB(B1, 0, 1); G8_STAGE(G8_SB(0, 0), b2, voffB);
      G8_BAR; G8_WAIT_L(0); G8_MMA(0, 1, At, B1); G8_BAR;
      G8_LDA(At, 0, 1); G8_STAGE(G8_SA(0, 0), a2, voffA);
      G8_BAR; G8_WAIT_L(0); G8_MMA(1, 0, At, B0); G8_BAR; G8_SCHED;
      G8_STAGE(G8_SB(0, 1), b2 + hstep, voffB);
      G8_WAIT_V(6); G8_BAR; G8_MMA(1, 1, At, B1); G8_BAR;
      G8_LDB(B0, 1, 0); G8_SCHED; G8_LDA(At, 1, 0); G8_STAGE(G8_SA(0, 1), a2 + hstep, voffA);
      G8_WAIT_L(8); G8_BAR; G8_WAIT_L(0); G8_MMA(0, 0, At, B0); G8_BAR; G8_SCHED;
      G8_LDB(B1, 1, 1); G8_STAGE(G8_SB(1, 0), b3, voffB);
      G8_BAR; G8_WAIT_L(0); G8_MMA(0, 1, At, B1); G8_BAR;
      G8_LDA(At, 1, 1); G8_STAGE(G8_SA(1, 0), a3, voffA);
      G8_BAR; G8_WAIT_L(0); G8_MMA(1, 0, At, B0); G8_BAR; G8_SCHED;
      G8_STAGE(G8_SB(1, 1), b3 + hstep, voffB);
      G8_WAIT_V(6); G8_BAR; G8_MMA(1, 1, At, B1); G8_BAR;
    }
    E(acc, cur, wr, wc, fr, fq);
    if (!has_next) break;
#pragma unroll
    for (int a = 0; a < 2; ++a)
#pragma unroll
      for (int b = 0; b < 2; ++b)
#pragma unroll
        for (int m = 0; m < 4; ++m)
#pragma unroll
          for (int n = 0; n < 2; ++n) acc[a][b][m][n] = zero4();
    cur = nxt; cA = nA; cB = nB; ++ui;
  }
  G8_WAIT_V(0);
  if (wr == 0) G8_BAR;
  G8_BAR;
#undef G8_SA
#undef G8_SB
#undef G8_STAGE
#undef G8_LDA
#undef G8_LDB
#undef G8_MMA
#undef G8_WAIT_V
#undef G8_WAIT_L
#undef G8_BAR
#undef G8_SCHED
}
}

DI uint4 pack8(f32x4 a, f32x4 b) { uint4 w; w.x = pk2(a[0], a[1]); w.y = pk2(a[2], a[3]); w.z = pk2(b[0], b[1]); w.w = pk2(b[2], b[3]); return w; }
DI void unpack8(uint4 w, f32x4& a, f32x4& b) { a[0] = bflo(w.x); a[1] = bfhi(w.x); a[2] = bflo(w.y); a[3] = bfhi(w.y); b[0] = bflo(w.z); b[1] = bfhi(w.z); b[2] = bflo(w.w); b[3] = bfhi(w.w); }

struct InprojSched {
  const u16* H; const u16* W; int G, c;
  __device__ __forceinline__ bool next(int i, g8::Unit& u) const {
    int pm, pn;
    if (!g8::order_next(i, G, c, TT / 256, NWP / 256, pm, pn)) return false;
    u.pm = pm; u.pn = pn;
    const bool sw = (pn >= 8 && pn < 12) || pn == 23 || pn == 25;
    u.kind = sw ? 1 : 0;
    const char* hp = (const char*)(H + (size_t)pm * 256 * DM); const char* wp = (const char*)(W + (size_t)pn * 256 * DM);
    u.a = sw ? wp : hp; u.b = sw ? hp : wp;
    return true;
  }
};
struct InprojEpi {
  const Params* pp;
  __device__ __forceinline__ void operator()(const f32x4 (&acc)[2][2][4][2], const g8::Unit& u, int wr, int wc, int fr, int fq) const {
    const Params& p = *pp;
    const int pn = u.pn, m0 = u.pm * 256, n0 = pn * 256, b = m0 >> 13;
    const int cb = 32 * wc + 8 * fq;
    if (u.kind) {
      u16* base; int f0, nf;
      if (pn < 12) { base = p.VaT; f0 = n0 - 2048; nf = 1024; }
      else if (pn == 23) { base = p.VsT; f0 = 0; nf = 256; }
      else { base = p.VwT; f0 = 0; nf = 256; }
      const int s0 = (m0 & (SQ - 1)) + 32 * wc + 16 * (fq & 1) + 4 * (fq >> 1);
#pragma unroll
      for (int ai = 0; ai < 2; ++ai)
#pragma unroll
        for (int m = 0; m < 4; ++m) {
          const int f = f0 + 128 * ai + 64 * wr + 16 * m + fr;
          u16* rowp = base + ((size_t)b * nf + f) * SQ + s0;
#pragma unroll
          for (int bj = 0; bj < 2; ++bj) {
            const f32x4 v0 = acc[ai][bj][m][0], v1 = acc[ai][bj][m][1];
            *(uint2*)(rowp + 128 * bj) = make_uint2(pk2(v0[0], v0[1]), pk2(v0[2], v0[3]));
            *(uint2*)(rowp + 128 * bj + 8) = make_uint2(pk2(v1[0], v1[1]), pk2(v1[2], v1[3]));
          }
        }
      return;
    }
    u16* dst; int ld, cbase, mode;
    if (pn < 4) { dst = p.Qa; ld = 1024; cbase = n0; mode = 4; }
    else if (pn < 8) { dst = p.Ka; ld = 1024; cbase = n0 - 1024; mode = 3; }
    else if (pn < 16) { dst = p.Za; ld = 1024; cbase = n0 - 3072; mode = 1; }
    else if (pn < 20) { dst = p.Qb; ld = 1024; cbase = n0 - 4096; mode = 5; }
    else if (pn == 20) { dst = p.KcR; ld = 256; cbase = 0; mode = 0; }
    else if (pn == 21) { dst = p.VcR; ld = 256; cbase = 0; mode = 0; }
    else if (pn == 22) { dst = p.Ks; ld = 256; cbase = 0; mode = 5; }
    else if (pn == 24) { dst = p.Kw; ld = 256; cbase = 0; mode = 5; }
    else if (pn < 30) { dst = p.Zb; ld = 1024; cbase = n0 - 6656; mode = 1; }
    else if (pn < 46) { dst = p.Mg; ld = 4096; cbase = n0 - 7680; mode = 2; }
    else { dst = nullptr; ld = 0; cbase = 0; mode = 6; }
#pragma unroll
    for (int ai = 0; ai < 2; ++ai)
#pragma unroll
      for (int m = 0; m < 4; ++m) {
        const int row = m0 + 128 * ai + 64 * wr + 16 * m + fr, s = row & (SQ - 1);
#pragma unroll
        for (int bj = 0; bj < 2; ++bj) {
          f32x4 v0 = acc[ai][bj][m][0], v1 = acc[ai][bj][m][1];
          if (mode == 3 || mode == 4) {
            if ((wc & 1) == 0) {
              const float4* t4 = (const float4*)(p.tabA + (size_t)s * 8);
              float4 ta = t4[0], tb = t4[1], tc = t4[2], td = t4[3];
              const float sg = (fq == 0) ? -1.f : 1.f;
              const bool act = fq < 2;
              f32x4 p0, p1;
#pragma unroll
              for (int j = 0; j < 4; ++j) { p0[j] = __shfl_xor(v0[j], 16); p1[j] = __shfl_xor(v1[j], 16); }
              if (act) {
                v0[0] = v0[0] * ta.x + sg * p0[0] * ta.y; v0[1] = v0[1] * ta.z + sg * p0[1] * ta.w;
                v0[2] = v0[2] * tb.x + sg * p0[2] * tb.y; v0[3] = v0[3] * tb.z + sg * p0[3] * tb.w;
                v1[0] = v1[0] * tc.x + sg * p1[0] * tc.y; v1[1] = v1[1] * tc.z + sg * p1[1] * tc.w;
                v1[2] = v1[2] * td.x + sg * p1[2] * td.y; v1[3] = v1[3] * td.z + sg * p1[3] * td.w;
              }
            }
            if (mode == 4) { v0 *= 0.125f; v1 *= 0.125f; }
          } else if (mode == 5) {
            if (wc == 0) {
              const float4* t4 = (const float4*)(p.tabB + (size_t)s * 16 + 8 * (fq & 1));
              float4 ta = t4[0], tb = t4[1], tc = t4[2], td = t4[3];
              const float sg = (fq < 2) ? -1.f : 1.f;
              f32x4 p0, p1;
#pragma unroll
              for (int j = 0; j < 4; ++j) { p0[j] = __shfl_xor(v0[j], 32); p1[j] = __shfl_xor(v1[j], 32); }
              v0[0] = v0[0] * ta.x + sg * p0[0] * ta.y; v0[1] = v0[1] * ta.z + sg * p0[1] * ta.w;
              v0[2] = v0[2] * tb.x + sg * p0[2] * tb.y; v0[3] = v0[3] * tb.z + sg * p0[3] * tb.w;
              v1[0] = v1[0] * tc.x + sg * p1[0] * tc.y; v1[1] = v1[1] * tc.z + sg * p1[1] * tc.w;
              v1[2] = v1[2] * td.x + sg * p1[2] * td.y; v1[3] = v1[3] * td.z + sg * p1[3] * td.w;
            }
          } else if (mode == 1) {
#pragma unroll
            for (int j = 0; j < 4; ++j) { v0[j] = silu_f(v0[j]); v1[j] = silu_f(v1[j]); }
          } else if (mode == 2 || mode == 6) {
#pragma unroll
            for (int j = 0; j < 4; ++j) { v0[j] = sigm_f(v0[j]); v1[j] = sigm_f(v1[j]); }
          }
          if (mode == 6) {
            if (bj == 0 && cb < 24) { float* bp = p.Bg + (size_t)row * 24 + cb; *(f32x4*)bp = v0; *(f32x4*)(bp + 4) = v1; }
          } else {
            *(uint4*)(dst + (size_t)row * ld + cbase + 128 * bj + cb) = pack8(v0, v1);
          }
        }
      }
  }
};
DI void phase_inproj(const Params& p, char* smem, int tid) {
  InprojSched S{p.H, p.WtIn, (int)gridDim.x, (int)blockIdx.x};
  InprojEpi E{&p};
  g8::gemm_phase<DM>((G8_LAS unsigned char*)smem, DM, S, E);
}

struct BranchSched {
  const u16* Mix; const u16* W; int G, c;
  __device__ __forceinline__ bool next(int i, g8::Unit& u) const {
    const long L = (long)i * G + c;
    if (L >= 2048) return false;
    const int half = (int)(L >> 10);
    int pm, pn;
    g8::order_next(i & ((1024 / G) - 1), G, c, TT / 256, DM / 256, pm, pn);
    u.pm = pm; u.pn = pn; u.kind = half;
    u.a = (const char*)(Mix + (size_t)pm * 256 * DM + half * 1024);
    u.b = (const char*)(W + (size_t)pn * 256 * DM + half * 1024);
    return true;
  }
};
struct BranchEpi {
  const Params* pp;
  __device__ __forceinline__ void operator()(const f32x4 (&acc)[2][2][4][2], const g8::Unit& u, int wr, int wc, int fr, int fq) const {
    const Params& p = *pp;
    const int m0 = u.pm * 256, n0 = u.pn * 256, cb = 32 * wc + 8 * fq;
#pragma unroll
    for (int ai = 0; ai < 2; ++ai)
#pragma unroll
      for (int m = 0; m < 4; ++m) {
        const size_t row = (size_t)(m0 + 128 * ai + 64 * wr + 16 * m + fr);
#pragma unroll
        for (int bj = 0; bj < 2; ++bj) {
          const int col = n0 + 128 * bj + cb;
          f32x4 g0, g1;
          unpack8(*(const uint4*)(p.Mg + row * 4096 + u.kind * 2048 + col), g0, g1);
          f32x4 v0 = acc[ai][bj][m][0] * g0, v1 = acc[ai][bj][m][1] * g1;
          uint4* mp = (uint4*)(p.Merged + row * DM + col);
          if (u.kind) { f32x4 o0, o1; unpack8(*mp, o0, o1); v0 += o0; v1 += o1; }
          *mp = pack8(v0, v1);
        }
      }
  }
};
DI void phase_branch(const Params& p, char* smem, int tid) {
  BranchSched S{p.H, p.WbT, (int)gridDim.x, (int)blockIdx.x};
  BranchEpi E{&p};
  g8::gemm_phase<DM>((G8_LAS unsigned char*)smem, 1024, S, E);
}

struct OutSched {
  const u16* A; const u16* W; int G, c;
  __device__ __forceinline__ bool next(int i, g8::Unit& u) const {
    int pm, pn;
    if (!g8::order_next(i, G, c, TT / 256, DM / 256, pm, pn)) return false;
    u.pm = pm; u.pn = pn; u.kind = 0;
    u.a = (const char*)(A + (size_t)pm * 256 * DM); u.b = (const char*)(W + (size_t)pn * 256 * DM);
    return true;
  }
};
struct OutEpi {
  const Params* pp;
  __device__ __forceinline__ void operator()(const f32x4 (&acc)[2][2][4][2], const g8::Unit& u, int wr, int wc, int fr, int fq) const {
    const Params& p = *pp;
    const int m0 = u.pm * 256, n0 = u.pn * 256, cb = 32 * wc + 8 * fq, b = m0 >> 13;
#pragma unroll
    for (int bj = 0; bj < 2; ++bj) {
      const int col = n0 + 128 * bj + cb;
      const f32x4 ga = *(const f32x4*)(p.mod + b * 6144 + 4096 + col), gb = *(const f32x4*)(p.mod + b * 6144 + 4096 + col + 4);
#pragma unroll
      for (int ai = 0; ai < 2; ++ai)
#pragma unroll
        for (int m = 0; m < 4; ++m) {
          const size_t idx = (size_t)(m0 + 128 * ai + 64 * wr + 16 * m + fr) * DM + col;
          *(uint4*)(p.Za + idx) = pack8(ga * acc[ai][bj][m][0], gb * acc[ai][bj][m][1]);
        }
    }
  }
};
DI void phase_outproj(const Params& p, char* smem, int tid) {
  OutSched S{p.Merged, p.WoT, (int)gridDim.x, (int)blockIdx.x};
  OutEpi E{&p};
  g8::gemm_phase<DM>((G8_LAS unsigned char*)smem, DM, S, E);
}

DI void cmp1_tile(const Params& p, int it, char* smem, int tid) {
  const int lane = tid & 63, wid = tid >> 6, wm = wid >> 1, wn = wid & 1;
  const int c = tid & 7, r = tid >> 3;
  {
    const int kv = it >> 5, tm = (it >> 1) & 15, tn = it & 1;
    const int m0 = tm * 256, n0 = tn * 128;
    f32x4 acc[4][4];
#pragma unroll
    for (int i = 0; i < 4; ++i)
#pragma unroll
      for (int j = 0; j < 4; ++j) acc[i][j] = zero4();
    const u16* raw = kv ? p.VcR : p.KcR;
    const u16* ap[4]; const u16* bp[2];
#pragma unroll
    for (int i = 0; i < 4; ++i) {
      int rr = m0 + r + 64 * i; if (rr > 4087) rr = 4087;
      int b = rr / 1022, rem = rr - b * 1022, n = rem >> 1, g = rem & 1;
      ap[i] = raw + ((size_t)(b * SQ + n * 16)) * 256 + g * 128 + c * 8;
    }
#pragma unroll
    for (int i = 0; i < 2; ++i) bp[i] = p.W1T + (size_t)kv * 256 * 4096 + (size_t)(n0 + r + 64 * i) * 4096 + c * 8;
    gemm_main(acc, ap, [](int kt) __attribute__((always_inline)) { return (long)(kt >> 1) * 256 + (kt & 1) * 64; }, bp, 64, smem, tid);
    const int lr = lane & 15;
#pragma unroll
    for (int nt = 0; nt < 4; ++nt) {
      float cv = p.cvec[kv * 256 + n0 + wn * 64 + nt * 16 + lr];
#pragma unroll
      for (int mt = 0; mt < 4; ++mt)
#pragma unroll
        for (int i = 0; i < 4; ++i) acc[mt][nt][i] = silu_f(acc[mt][nt][i] + cv);
    }
    store_rm(acc, p.Hc + (size_t)kv * 4096 * 256, 256, m0 + wm * 64, n0 + wn * 64, lane);
  }
}

DI void phase_cmp2(const Params& p, char* smem, int tid) {
  const int lane = tid & 63, wid = tid >> 6, wm = wid >> 1, wn = wid & 1, lr = lane & 15, quad = lane >> 4;
  const int c = tid & 7, r = tid >> 3;
  for (int it = blockIdx.x; it < 32; it += gridDim.x) {
    const int kv = it >> 4, tm = it & 15, m0 = tm * 256;
    f32x4 acc[4][4];
#pragma unroll
    for (int i = 0; i < 4; ++i)
#pragma unroll
      for (int j = 0; j < 4; ++j) acc[i][j] = zero4();
    const u16* ap[4]; const u16* bp[2];
#pragma unroll
    for (int i = 0; i < 4; ++i) ap[i] = p.Hc + (size_t)kv * 4096 * 256 + (size_t)(m0 + r + 64 * i) * 256 + c * 8;
#pragma unroll
    for (int i = 0; i < 2; ++i) bp[i] = p.W2T + (size_t)kv * 128 * 256 + (size_t)(r + 64 * i) * 256 + c * 8;
    gemm_main(acc, ap, [](int kt) __attribute__((always_inline)) { return (long)kt * 64; }, bp, 4, smem, tid);
#pragma unroll
    for (int mt = 0; mt < 4; ++mt)
#pragma unroll
      for (int i = 0; i < 4; ++i) {
        int rr = m0 + wm * 64 + mt * 16 + quad * 4 + i;
        if (rr < 4088) {
          int b = rr / 1022, rem = rr - b * 1022, n = rem >> 1, g = rem & 1, bg = b * 2 + g;
          if (kv == 0) {
            float v0 = acc[mt][0][i], v1 = acc[mt][1][i];
            if (wn == 0) {
              float2 cs = p.tabB[(n * 16 + 31) * 16 + lr];
              float t0 = v0 * cs.x - v1 * cs.y, t1 = v1 * cs.x + v0 * cs.y; v0 = t0; v1 = t1;
            }
            u16* d = p.Kc + ((size_t)bg * 512 + n) * 128 + wn * 64 + lr;
            d[0] = f2bf(v0); d[16] = f2bf(v1); d[32] = f2bf(acc[mt][2][i]); d[48] = f2bf(acc[mt][3][i]);
          } else {
            const int u = n & 31, npos = (n & ~31) + ((u < 16) ? (8 * (u >> 2) + (u & 3)) : (8 * ((u - 16) >> 2) + 4 + (u & 3)));
#pragma unroll
            for (int nt = 0; nt < 4; ++nt)
              p.VcT[((size_t)bg * 128 + wn * 64 + nt * 16 + lr) * 512 + npos] = f2bf(acc[mt][nt][i]);
          }
        }
      }
  }
}

template <class F>
DI void kv_pipeline(int jlo, int jhi, const u16* kb, int ldk, const u16* vb, int ldv, char* smem, int tid, F&& body) {
  const int wid = __builtin_amdgcn_readfirstlane(tid >> 6), lane = tid & 63;
  unsigned ksrc[2], vsrc[2];
#pragma unroll
  for (int i = 0; i < 2; ++i) {
    const int row = (i * 8 + wid) * 4 + (lane >> 4), chunk = (lane & 15) ^ (row & 15);
    ksrc[i] = (unsigned)(row * ldk + chunk * 8) * 2u;
    const int d = (i * 8 + wid) * 8 + (lane >> 3), c16 = (lane & 7) ^ ((d >> 1) & 7);
    vsrc[i] = (unsigned)(d * ldv + c16 * 8) * 2u;
  }
  G8_LAS unsigned char* lds = (G8_LAS unsigned char*)smem;
  const unsigned ldsw = (unsigned)wid * 1024u;
#define KV_ISSUE(j, buf) do { const char* _kg = (const char*)(kb + (size_t)(j) * 64 * ldk); const char* _vg = (const char*)(vb + (size_t)(j) * 64); \
    _Pragma("unroll") for (int _i = 0; _i < 2; ++_i) { \
      __builtin_amdgcn_global_load_lds((const unsigned*)(_kg + ksrc[_i]), (G8_LAS unsigned*)(lds + (buf) * 32768 + _i * 8192 + ldsw), 16, 0, 0); \
      __builtin_amdgcn_global_load_lds((const unsigned*)(_vg + vsrc[_i]), (G8_LAS unsigned*)(lds + (buf) * 32768 + 16384 + _i * 8192 + ldsw), 16, 0, 0); } } while (0)
  __syncthreads();
  KV_ISSUE(jlo, 0);
  if (jlo + 1 <= jhi) KV_ISSUE(jlo + 1, 1);
  asm volatile("s_waitcnt vmcnt(0)" ::: "memory");
  __syncthreads();
  int buf = 0;
  for (int j = jlo; j <= jhi; j += 2) {
    if (j + 2 <= jhi) KV_ISSUE(j + 2, (buf ^ 1) * 2);
    if (j + 3 <= jhi) KV_ISSUE(j + 3, (buf ^ 1) * 2 + 1);
#pragma unroll 1
    for (int t = 0; t < 2; ++t) {
      if (j + t > jhi) break;
      const char* tb = (const char*)(smem + buf * 65536 + t * 32768);
      body(j + t, tb, tb + 16384);
    }
    asm volatile("s_waitcnt vmcnt(0)" ::: "memory");
    __syncthreads();
    buf ^= 1;
  }
#undef KV_ISSUE
}

#define SB0 __builtin_amdgcn_sched_barrier(0)
template <int NKK>
DI void load_kfrags(bf16x8 (&kf)[4][NKK], const char* Kb, int chunk0, int lr, int quad) {
#pragma unroll
  for (int kt = 0; kt < 4; ++kt)
#pragma unroll
    for (int kk = 0; kk < NKK; ++kk)
      kf[kt][kk] = *(const bf16x8*)(Kb + (kt * 16 + lr) * 256 + (((chunk0 + kk * 4 + quad) ^ lr) << 4));
}
template <int NKK>
DI void mma_S(f32x4 (&s)[4], const bf16x8 (&kf)[4][NKK], const bf16x8 (&qf)[NKK]) {
#pragma unroll
  for (int kt = 0; kt < 4; ++kt) {
    s[kt] = zero4();
#pragma unroll
    for (int kk = 0; kk < NKK; ++kk) s[kt] = mfma16(kf[kt][kk], qf[kk], s[kt]);
  }
}
DI bf16x8 load_vfrag(const char* Vb, int s2, int dt, int lr, int quad) {
  return *(const bf16x8*)(Vb + (dt * 16 + lr) * 128 + ((((s2 * 4 + quad) ^ (lr >> 1))) << 4));
}
DI void load_vgroup(bf16x8 (&vf)[8], const char* Vb, int s2, int lr, int quad) {
#pragma unroll
  for (int dt = 0; dt < 8; ++dt) vf[dt] = load_vfrag(Vb, s2, dt, lr, quad);
}
DI void mma_PV(f32x4 (&o)[8], const bf16x8 (&vf)[8], bf16x8 pf) {
#pragma unroll
  for (int dt = 0; dt < 8; ++dt) o[dt] = mfma16(vf[dt], pf, o[dt]);
}
DI void mma_PV2(f32x4 (&o0)[8], f32x4 (&o1)[8], const bf16x8 (&vf)[8], bf16x8 p0, bf16x8 p1) {
#pragma unroll
  for (int dt = 0; dt < 8; ++dt) { o0[dt] = mfma16(vf[dt], p0, o0[dt]); o1[dt] = mfma16(vf[dt], p1, o1[dt]); }
}
DI void ldk4(bf16x8 (&k)[4], const char* Kb, int kt, int lr, int quad) {
#pragma unroll
  for (int kk = 0; kk < 4; ++kk) k[kk] = *(const bf16x8*)(Kb + (kt * 16 + lr) * 256 + (((kk * 4 + quad) ^ lr) << 4));
}
DI f32x4 mma4(const bf16x8 (&k)[4], const bf16x8 (&qf)[4]) {
  f32x4 a = zero4();
  __builtin_amdgcn_s_setprio(1);
#pragma unroll
  for (int kk = 0; kk < 4; ++kk) a = mfma16(k[kk], qf[kk], a);
  __builtin_amdgcn_s_setprio(0);
  return a;
}
DI void ldv4(bf16x8 (&v)[4], const char* Vb, int qtr, int lr, int quad) {
#pragma unroll
  for (int i = 0; i < 4; ++i) v[i] = load_vfrag(Vb, qtr >> 1, 4 * (qtr & 1) + i, lr, quad);
}
DI void nsa_S(f32x4 (&s)[4], const char* Kb, const char* Vb, const bf16x8 (&qf)[4], bf16x8 (&v0)[4], int lr, int quad) {
  bf16x8 k0[4], k1[4], k2[4], k3[4];
  ldk4(k0, Kb, 0, lr, quad); SB0;
  ldk4(k1, Kb, 1, lr, quad); s[0] = mma4(k0, qf); SB0;
  ldk4(k2, Kb, 2, lr, quad); s[1] = mma4(k1, qf); SB0;
  ldk4(k3, Kb, 3, lr, quad); s[2] = mma4(k2, qf); SB0;
  ldv4(v0, Vb, 0, lr, quad); s[3] = mma4(k3, qf); SB0;
}
DI void nsa_PV(f32x4 (&o)[8], const char* Vb, const bf16x8 (&pf)[2], bf16x8 (&v0)[4], int lr, int quad) {
  bf16x8 v1[4], v2[4], v3[4];
  SB0;
  ldv4(v1, Vb, 1, lr, quad);
  __builtin_amdgcn_s_setprio(1);
#pragma unroll
  for (int i = 0; i < 4; ++i) o[i] = mfma16(v0[i], pf[0], o[i]);
  __builtin_amdgcn_s_setprio(0);
  SB0;
  ldv4(v2, Vb, 2, lr, quad);
  __builtin_amdgcn_s_setprio(1);
#pragma unroll
  for (int i = 0; i < 4; ++i) o[4 + i] = mfma16(v1[i], pf[0], o[4 + i]);
  __builtin_amdgcn_s_setprio(0);
  SB0;
  ldv4(v3, Vb, 3, lr, quad);
  __builtin_amdgcn_s_setprio(1);
#pragma unroll
  for (int i = 0; i < 4; ++i) o[i] = mfma16(v2[i], pf[1], o[i]);
  __builtin_amdgcn_s_setprio(0);
  SB0;
  __builtin_amdgcn_s_setprio(1);
#pragma unroll
  for (int i = 0; i < 4; ++i) o[4 + i] = mfma16(v3[i], pf[1], o[4 + i]);
  __builtin_amdgcn_s_setprio(0);
}
DI void ldk2(bf16x8 (&k)[2], const char* Kb, int step, int lr, int quad) {
  const int m = step >> 2, kt = step & 3;
#pragma unroll
  for (int kk = 0; kk < 2; ++kk) k[kk] = *(const bf16x8*)(Kb + (kt * 16 + lr) * 256 + (((m * 8 + kk * 4 + quad) ^ lr) << 4));
}
DI f32x4 mma2(const bf16x8 (&k)[2], const bf16x8 (&qf)[2]) {
  f32x4 a = zero4();
  __builtin_amdgcn_s_setprio(1);
  a = mfma16(k[0], qf[0], a); a = mfma16(k[1], qf[1], a);
  __builtin_amdgcn_s_setprio(0);
  return a;
}
DI void diff_S(f32x4 (&s0)[4], f32x4 (&s1)[4], const char* Kb, const char* Vb, const bf16x8 (&qf0)[2], const bf16x8 (&qf1)[2],
               bf16x8 (&v0)[4], bf16x8 (&v1)[4], int lr, int quad) {
  bf16x8 f0[2], f1[2], f2[2], f3[2], f4[2], f5[2], f6[2], f7[2];
  ldk2(f0, Kb, 0, lr, quad); ldk2(f1, Kb, 1, lr, quad); ldk2(f2, Kb, 2, lr, quad); ldk2(f3, Kb, 3, lr, quad); SB0;
  ldk2(f4, Kb, 4, lr, quad); s0[0] = mma2(f0, qf0); SB0;
  ldk2(f5, Kb, 5, lr, quad); s0[1] = mma2(f1, qf0); SB0;
  ldk2(f6, Kb, 6, lr, quad); s0[2] = mma2(f2, qf0); SB0;
  ldk2(f7, Kb, 7, lr, quad); s0[3] = mma2(f3, qf0); SB0;
  ldv4(v0, Vb, 0, lr, quad); s1[0] = mma2(f4, qf1); s1[1] = mma2(f5, qf1); SB0;
  ldv4(v1, Vb, 1, lr, quad); s1[2] = mma2(f6, qf1); s1[3] = mma2(f7, qf1); SB0;
}
DI void diff_PV(f32x4 (&o0)[8], f32x4 (&o1)[8], const char* Vb, const bf16x8 (&p0)[2], const bf16x8 (&p1)[2], bf16x8 (&v0)[4], bf16x8 (&v1)[4], int lr, int quad) {
  bf16x8 v2[4], v3[4];
  SB0;
  ldv4(v2, Vb, 2, lr, quad);
  __builtin_amdgcn_s_setprio(1);
#pragma unroll
  for (int i = 0; i < 4; ++i) { o0[i] = mfma16(v0[i], p0[0], o0[i]); o1[i] = mfma16(v0[i], p1[0], o1[i]); }
  __builtin_amdgcn_s_setprio(0);
  SB0;
  ldv4(v3, Vb, 3, lr, quad);
  __builtin_amdgcn_s_setprio(1);
#pragma unroll
  for (int i = 0; i < 4; ++i) { o0[4 + i] = mfma16(v1[i], p0[0], o0[4 + i]); o1[4 + i] = mfma16(v1[i], p1[0], o1[4 + i]); }
  __builtin_amdgcn_s_setprio(0);
  SB0;
  __builtin_amdgcn_s_setprio(1);
#pragma unroll
  for (int i = 0; i < 4; ++i) { o0[i] = mfma16(v2[i], p0[1], o0[i]); o1[i] = mfma16(v2[i], p1[1], o1[i]); }
  __builtin_amdgcn_s_setprio(0);
  __builtin_amdgcn_s_setprio(1);
#pragma unroll
  for (int i = 0; i < 4; ++i) { o0[4 + i] = mfma16(v3[i], p0[1], o0[4 + i]); o1[4 + i] = mfma16(v3[i], p1[1], o1[4 + i]); }
  __builtin_amdgcn_s_setprio(0);
}
DI void pack_p(const f32x4 (&s)[4], bf16x8 (&pf)[2]) {
#pragma unroll
  for (int s2 = 0; s2 < 2; ++s2)
    pf[s2] = mk8(pk2(s[2 * s2][0], s[2 * s2][1]), pk2(s[2 * s2][2], s[2 * s2][3]),
                 pk2(s[2 * s2 + 1][0], s[2 * s2 + 1][1]), pk2(s[2 * s2 + 1][2], s[2 * s2 + 1][3]));
}
template <class MF>
DI void flash_update(f32x4 (&s)[4], float scl, float& mx, float& ls, f32x4 (&o)[8], MF maskfn, bool lane_on, bool masked) {
  if (masked) {
#pragma unroll
    for (int kt = 0; kt < 4; ++kt)
#pragma unroll
      for (int i = 0; i < 4; ++i) { if (maskfn(kt, i)) s[kt][i] = -1e30f; }
  }
  float tmax = -1e30f;
#pragma unroll
  for (int kt = 0; kt < 4; ++kt)
#pragma unroll
    for (int i = 0; i < 4; ++i) tmax = fmaxf(tmax, s[kt][i]);
  tmax = rowmax4(tmax);
  if (!lane_on) tmax = -1e30f;
  const float th = 8.f / scl;
  if (__any(tmax > mx + th)) {
    const float mnew = fmaxf(mx, tmax);
    const float alpha = ex2((mx - mnew) * scl);
    ls *= alpha;
#pragma unroll
    for (int dt = 0; dt < 8; ++dt) o[dt] *= alpha;
    mx = mnew;
  }
  const float off = lane_on ? -mx * scl : -1e30f;
  float rs = 0.f;
  if (masked) {
#pragma unroll
    for (int kt = 0; kt < 4; ++kt)
#pragma unroll
      for (int i = 0; i < 4; ++i) {
        float pv = ex2(fmaf(s[kt][i], scl, off));
        pv = (s[kt][i] > -1e29f) ? pv : 0.f;
        s[kt][i] = pv; rs += pv;
      }
  } else {
#pragma unroll
    for (int kt = 0; kt < 4; ++kt)
#pragma unroll
      for (int i = 0; i < 4; ++i) { const float pv = ex2(fmaf(s[kt][i], scl, off)); s[kt][i] = pv; rs += pv; }
  }
  ls += rs;
}

DI void ldk2m(bf16x8 (&k)[2], const char* Kb, int m, int kt, int lr, int quad) {
#pragma unroll
  for (int kk = 0; kk < 2; ++kk) k[kk] = *(const bf16x8*)(Kb + (kt * 16 + lr) * 256 + (((m * 8 + kk * 4 + quad) ^ lr) << 4));
}
DI void diff_S2(f32x4 (&s0)[4], f32x4 (&s1)[4], const char* Kb, const char* Vb, int m, const bf16x8 (&q0)[2], const bf16x8 (&q1)[2],
                bf16x8 (&v0)[4], bf16x8 (&v1)[4], int lr, int quad) {
  bf16x8 f0[2], f1[2], f2[2], f3[2];
  ldk2m(f0, Kb, m, 0, lr, quad); ldk2m(f1, Kb, m, 1, lr, quad); SB0;
  ldk2m(f2, Kb, m, 2, lr, quad); s0[0] = mma2(f0, q0); s1[0] = mma2(f0, q1); SB0;
  ldk2m(f3, Kb, m, 3, lr, quad); s0[1] = mma2(f1, q0); s1[1] = mma2(f1, q1); SB0;
  ldv4(v0, Vb, 0, lr, quad); s0[2] = mma2(f2, q0); s1[2] = mma2(f2, q1); SB0;
  ldv4(v1, Vb, 1, lr, quad); s0[3] = mma2(f3, q0); s1[3] = mma2(f3, q1); SB0;
}
DI void diff_item(const Params& p, int b, int h, int qb, float lam, char* smem, int tid) {
  const int lane = tid & 63, wid = tid >> 6, lr = lane & 15, quad = lane >> 4;
  const int m = wid >> 2, qg = wid & 3;
  const int qw = qb * 128 + qg * 32, qp0 = qw + lr, qp1 = qw + 16 + lr;
  f32x4 o0[8], o1[8];
#pragma unroll
  for (int dt = 0; dt < 8; ++dt) { o0[dt] = zero4(); o1[dt] = zero4(); }
  float mx0 = -1e30f, mx1 = -1e30f, ls0 = 0.f, ls1 = 0.f;
  bf16x8 qf0[2], qf1[2];
  {
    const u16* qb0 = p.Qa + (size_t)(b * SQ + qp0) * 1024 + h * 128 + m * 64 + quad * 8;
    const u16* qb1 = p.Qa + (size_t)(b * SQ + qp1) * 1024 + h * 128 + m * 64 + quad * 8;
#pragma unroll
    for (int kk = 0; kk < 2; ++kk) { qf0[kk] = *(const bf16x8*)(qb0 + kk * 32); qf1[kk] = *(const bf16x8*)(qb1 + kk * 32); }
  }
  const u16* kb = p.Ka + (size_t)b * SQ * 1024 + h * 128;
  const u16* vb = p.VaT + (size_t)(b * 8 + h) * 128 * SQ;
  kv_pipeline(0, qb * 2 + 1, kb, 1024, vb, SQ, smem, tid, [&](int j, const char* Kb, const char* Vb) __attribute__((always_inline)) {
    const int key0 = j * 64;
    if (key0 > qw + 31) return;
    const bool diag = key0 + 63 > qw;
    auto mf0 = [&](int kt, int i) __attribute__((always_inline)) { return key0 + kt * 16 + quad * 4 + i > qp0; };
    auto mf1 = [&](int kt, int i) __attribute__((always_inline)) { return key0 + kt * 16 + quad * 4 + i > qp1; };
    f32x4 s0[4], s1[4];
    bf16x8 pf0[2], pf1[2];
    bf16x8 va[4], vb2[4];
    diff_S2(s0, s1, Kb, Vb, m, qf0, qf1, va, vb2, lr, quad);
    flash_update(s0, LOG2E, mx0, ls0, o0, mf0, true, diag);
    flash_update(s1, LOG2E, mx1, ls1, o1, mf1, true, diag);
    pack_p(s0, pf0);
    pack_p(s1, pf1);
    diff_PV(o0, o1, Vb, pf0, pf1, va, vb2, lr, quad);
  });
  {
    float la = ls0, lb = ls1;
    la += __shfl_xor(la, 16); la += __shfl_xor(la, 32);
    lb += __shfl_xor(lb, 16); lb += __shfl_xor(lb, 32);
    f32x4* X = (f32x4*)smem;
    if (m == 1) {
      const float ca = lam / la, cb = lam / lb;
#pragma unroll
      for (int dt = 0; dt < 8; ++dt) { X[((qg * 2 + 0) * 8 + dt) * 64 + lane] = o0[dt] * ca; X[((qg * 2 + 1) * 8 + dt) * 64 + lane] = o1[dt] * cb; }
    }
    __syncthreads();
    if (m == 0) {
#pragma unroll
      for (int qt = 0; qt < 2; ++qt) {
        const float i1 = 1.f / (qt ? lb : la);
        f32x4 ov[8];
        float ss = 0.f;
#pragma unroll
        for (int dt = 0; dt < 8; ++dt) {
          ov[dt] = (qt ? o1[dt] : o0[dt]) * i1 - X[((qg * 2 + qt) * 8 + dt) * 64 + lane];
          ss += ov[dt][0] * ov[dt][0] + ov[dt][1] * ov[dt][1] + ov[dt][2] * ov[dt][2] + ov[dt][3] * ov[dt][3];
        }
        ss += __shfl_xor(ss, 16); ss += __shfl_xor(ss, 32);
        const float rn = rsqrtf(ss * (1.f / 128.f) + EPSN) * 0.8f;
        const size_t t = (size_t)(b * SQ + (qt ? qp1 : qp0));
#pragma unroll
        for (int dt = 0; dt < 8; ++dt) {
          const int d0 = dt * 16 + quad * 4;
          float4 g = *(const float4*)(p.diff_g + d0);
          uint2 z = *(const uint2*)(p.Za + t * 1024 + h * 128 + d0);
          float v0 = ov[dt][0] * rn * g.x * bflo(z.x), v1 = ov[dt][1] * rn * g.y * bfhi(z.x);
          float v2 = ov[dt][2] * rn * g.z * bflo(z.y), v3 = ov[dt][3] * rn * g.w * bfhi(z.y);
          uint2 w = {pk2(v0, v1), pk2(v2, v3)};
          *(uint2*)(p.H + t * DM + h * 128 + d0) = w;
        }
      }
    }
  }
}

DI void nsa_item(const Params& p, int b, int g, int qb, char* smem, int tid) {
  const int lane = tid & 63, wid = tid >> 6, lr = lane & 15, quad = lane >> 4;
  const int hh = lr & 3, qi = wid * 4 + (lr >> 2), h = g * 4 + hh, bg = b * 2 + g;
  const int q0 = qb * 32, qp = q0 + qi, cur = q0 >> 6;
  float* imp = (float*)(smem + 131072);
  unsigned* sel = (unsigned*)(smem + 131072 + 32 * 132 * 4);
  const float SCL = 0.08838834764831845f * LOG2E;
  bf16x8 qf[4];
#pragma unroll
  for (int kk = 0; kk < 4; ++kk) qf[kk] = *(const bf16x8*)(p.Qb + (size_t)(b * SQ + qp) * 1024 + h * 128 + kk * 32 + quad * 8);
  float gt[3];
#pragma unroll
  for (int br = 0; br < 3; ++br) gt[br] = p.Bg[(size_t)(b * SQ + qp) * 24 + h * 3 + br];
  uint2 oc[8];
  f32x4 o[8];
#pragma unroll
  for (int dt = 0; dt < 8; ++dt) { oc[dt] = make_uint2(0u, 0u); o[dt] = zero4(); }
  __syncthreads();
  for (int i = tid; i < 32 * 132; i += NTHR) imp[i] = 0.f;
  if (tid < 128) sel[tid] = 0u;
  const u16* kcb = p.Kc + (size_t)bg * 512 * 128;
  const u16* vcb = p.VcT + (size_t)bg * 128 * 512;
  const int ncv = q0 / 16 + 1;
  const int nct = (ncv + 63) >> 6;
  const int cmax = (qp - 31) >> 4;
  float mx = -1e30f, ls = 0.f;
  kv_pipeline(0, nct - 1, kcb, 128, vcb, 512, smem, tid, [&](int j, const char* Kb, const char* Vb) __attribute__((always_inline)) {
    f32x4 s[4];
    bf16x8 va[4];
    nsa_S(s, Kb, Vb, qf, va, lr, quad);
    float tmax = -1e30f;
#pragma unroll
    for (int kt = 0; kt < 4; ++kt)
#pragma unroll
      for (int i = 0; i < 4; ++i) {
        int cc = j * 64 + kt * 16 + quad * 4 + i;
        float v = (cc <= cmax) ? s[kt][i] * SCL : -1e30f;
        s[kt][i] = v; tmax = fmaxf(tmax, v);
      }
    tmax = rowmax4(tmax);
    float mnew = fmaxf(mx, tmax), rs = 0.f;
#pragma unroll
    for (int kt = 0; kt < 4; ++kt)
#pragma unroll
      for (int i = 0; i < 4; ++i) { float v = s[kt][i]; rs += (v > -1e29f) ? ex2(v - mnew) : 0.f; }
    ls = ls * ex2(mx - mnew) + rs; mx = mnew;
  });
  float inv;
  {
    float l = ls; l += __shfl_xor(l, 16); l += __shfl_xor(l, 32);
    inv = (l > 0.f) ? 1.f / l : 0.f;
  }
  kv_pipeline(0, nct - 1, kcb, 128, vcb, 512, smem, tid, [&](int j, const char* Kb, const char* Vb) __attribute__((always_inline)) {
    f32x4 s[4];
    bf16x8 va[4];
    nsa_S(s, Kb, Vb, qf, va, lr, quad);
    float* irow = imp + qi * 132;
#pragma unroll
    for (int kt = 0; kt < 4; ++kt) {
      float a = 0.f;
#pragma unroll
      for (int i = 0; i < 4; ++i) {
        int cc = j * 64 + kt * 16 + quad * 4 + i;
        float pv = (cc <= cmax) ? ex2(s[kt][i] * SCL - mx) * inv : 0.f;
        s[kt][i] = pv; a += pv;
      }
      if (a != 0.f) {
        int n1 = j * 16 + kt * 4 + quad;
        atomicAdd(irow + n1, a);
        if (s[kt][3] != 0.f) atomicAdd(irow + n1 + 1, s[kt][3]);
      }
    }
    bf16x8 pf[2];
    pack_p(s, pf);
    nsa_PV(o, Vb, pf, va, lr, quad);
  });
#pragma unroll
  for (int dt = 0; dt < 8; ++dt) { f32x4 t = o[dt] * gt[0]; oc[dt] = make_uint2(pk2(t[0], t[1]), pk2(t[2], t[3])); o[dt] = zero4(); }
  {
    const int q = tid >> 4, sub = tid & 15;
    float v[8];
#pragma unroll
    for (int jj = 0; jj < 8; ++jj) {
      int n = sub + 16 * jj;
      float x = imp[q * 132 + n];
      bool forced = (n == 0) | (n == cur) | (n == cur - 1);
      x = (n <= cur) ? (forced ? 1e4f : x) : -1e30f;
      v[jj] = x; imp[q * 132 + n] = x;
    }
    __syncthreads();
    int rk[8];
#pragma unroll
    for (int jj = 0; jj < 8; ++jj) rk[jj] = 0;
    for (int n2 = 0; n2 <= cur; ++n2) {
      float y = imp[q * 132 + n2];
#pragma unroll
      for (int jj = 0; jj < 8; ++jj) {
        int n = sub + 16 * jj;
        rk[jj] += ((y > v[jj]) | ((y == v[jj]) & (n2 < n))) ? 1 : 0;
      }
    }
#pragma unroll
    for (int jj = 0; jj < 8; ++jj) {
      int n = sub + 16 * jj;
      if (n <= cur && rk[jj] < 16) atomicOr(&sel[q * 4 + (n >> 5)], 1u << (n & 31));
    }
  }
  {
    float mx2 = -1e30f, l2 = 0.f;
    const u16* kb = p.Ks + (size_t)b * SQ * 256 + g * 128;
    const u16* vb = p.VsT + (size_t)bg * 128 * SQ;
    kv_pipeline(0, cur, kb, 256, vb, SQ, smem, tid, [&](int j, const char* Kb, const char* Vb) __attribute__((always_inline)) {
      const bool sb = (sel[qi * 4 + (j >> 5)] >> (j & 31)) & 1u;
      if (!__any(sb)) return;
      f32x4 s[4];
      bf16x8 va[4];
      nsa_S(s, Kb, Vb, qf, va, lr, quad);
      auto mf = [&](int kt, int i) __attribute__((always_inline)) { return j * 64 + kt * 16 + quad * 4 + i > qp; };
      flash_update(s, SCL, mx2, l2, o, mf, sb, j == cur);
      bf16x8 pf[2];
      pack_p(s, pf);
      nsa_PV(o, Vb, pf, va, lr, quad);
    });
    float l = l2; l += __shfl_xor(l, 16); l += __shfl_xor(l, 32);
    float f = (l > 0.f) ? gt[1] / l : 0.f;
#pragma unroll
    for (int dt = 0; dt < 8; ++dt) {
      f32x4 t = o[dt] * f;
      oc[dt] = make_uint2(pk2(bflo(oc[dt].x) + t[0], bfhi(oc[dt].x) + t[1]), pk2(bflo(oc[dt].y) + t[2], bfhi(oc[dt].y) + t[3]));
      o[dt] = zero4();
    }
  }
  {
    float mx2 = -1e30f, l2 = 0.f;
    const u16* kb = p.Kw + (size_t)b * SQ * 256 + g * 128;
    const u16* vb = p.VwT + (size_t)bg * 128 * SQ;
    int jlo = (q0 - 511) >> 6; if (jlo < 0) jlo = 0;
    kv_pipeline(jlo, cur, kb, 256, vb, SQ, smem, tid, [&](int j, const char* Kb, const char* Vb) __attribute__((always_inline)) {
      f32x4 s[4];
      bf16x8 va[4];
      nsa_S(s, Kb, Vb, qf, va, lr, quad);
      auto mf = [&](int kt, int i) __attribute__((always_inline)) {
        int key = j * 64 + kt * 16 + quad * 4 + i;
        return (key > qp) || (key <= qp - 512);
      };
      flash_update(s, SCL, mx2, l2, o, mf, true, !(j * 64 + 63 <= q0 && j * 64 > q0 + 31 - 512));
      bf16x8 pf[2];
      pack_p(s, pf);
      nsa_PV(o, Vb, pf, va, lr, quad);
    });
    float l = l2; l += __shfl_xor(l, 16); l += __shfl_xor(l, 32);
    float f = (l > 0.f) ? gt[2] / l : 0.f;
#pragma unroll
    for (int dt = 0; dt < 8; ++dt) o[dt] = o[dt] * f + (f32x4){bflo(oc[dt].x), bfhi(oc[dt].x), bflo(oc[dt].y), bfhi(oc[dt].y)};
  }
  {
    const size_t t = (size_t)(b * SQ + qp);
#pragma unroll
    for (int dt = 0; dt < 8; ++dt) {
      const int d0 = dt * 16 + quad * 4;
      uint2 z = *(const uint2*)(p.Zb + t * 1024 + h * 128 + d0);
      uint2 w = {pk2(o[dt][0] * bflo(z.x), o[dt][1] * bfhi(z.x)), pk2(o[dt][2] * bflo(z.y), o[dt][3] * bfhi(z.y))};
      *(uint2*)(p.H + t * DM + 1024 + h * 128 + d0) = w;
    }
  }
}

DI void phase_diff(const Params& p, char* smem, int tid0) {
  int tid = tid0;
  float s1 = 0.f, s2 = 0.f;
  for (int i = 0; i < 64; ++i) { s1 += p.lq1[i] * p.lk1[i]; s2 += p.lq2[i] * p.lk2[i]; }
  const float lam = expf(s1) - expf(s2) + 0.2f;
  int* s_item = (int*)(smem + SMEM_BYTES - 16);
  for (;;) {
    __syncthreads();
    if (tid == 0) *s_item = atomicAdd(p.ctr, 1);
    __syncthreads();
    int it = *s_item;
    if (it >= 64 + 2048) break;
    asm volatile("" : "+v"(tid));
    if (it < 64) { cmp1_tile(p, it, smem, tid); continue; }
    it -= 64;
    const int r = 63 - (it >> 5), k = it & 31;
    diff_item(p, k >> 3, k & 7, r, lam, smem, tid);
  }
}
DI void phase_nsa(const Params& p, char* smem, int tid0) {
  int tid = tid0;
  int* s_item = (int*)(smem + SMEM_BYTES - 16);
  for (;;) {
    __syncthreads();
    if (tid == 0) *s_item = atomicAdd(p.ctr + 1, 1);
    __syncthreads();
    const int it = *s_item;
    if (it >= 2048) break;
    asm volatile("" : "+v"(tid));
    const int kk = it & 7;
    nsa_item(p, kk >> 1, kk & 1, 255 - (it >> 3), smem, tid);
  }
}

DI void phase_final(const Params& p, int tid) {
  const int lane = tid & 63, wid = tid >> 6;
  for (int it = blockIdx.x; it < TT / 16; it += gridDim.x) {
#pragma unroll 1
    for (int rr = 0; rr < 2; ++rr) {
      int row = it * 16 + wid * 2 + rr;
      float4* xr = (float4*)(p.out + (size_t)row * DM);
      const float4* xin = (const float4*)(p.x + (size_t)row * DM);
      const uint2* yin = (const uint2*)(p.Za + (size_t)row * DM);
      float4 v[8]; float ss = 0;
#pragma unroll
      for (int i = 0; i < 8; ++i) {
        float4 xv = xin[lane + 64 * i]; uint2 yv = yin[lane + 64 * i];
        v[i] = make_float4(xv.x + bflo(yv.x), xv.y + bfhi(yv.x), xv.z + bflo(yv.y), xv.w + bfhi(yv.y));
        ss += v[i].x * v[i].x + v[i].y * v[i].y + v[i].z * v[i].z + v[i].w * v[i].w;
      }
      ss = wave_sum(ss);
      float rs = rsqrtf(ss * (1.f / DM) + EPSN);
      const float4* g4 = (const float4*)p.fin_g;
#pragma unroll
      for (int i = 0; i < 8; ++i) {
        float4 g = g4[lane + 64 * i];
        xr[lane + 64 * i] = make_float4(v[i].x * rs * g.x, v[i].y * rs * g.y, v[i].z * rs * g.z, v[i].w * rs * g.w);
      }
    }
  }
}

DI void grid_bar(int* cnt, int target) {
  __syncthreads();
  if (threadIdx.x == 0) {
    __builtin_amdgcn_fence(__ATOMIC_RELEASE, "agent");
    asm volatile("s_waitcnt vmcnt(0)" ::: "memory");
    __hip_atomic_fetch_add(cnt, 1, __ATOMIC_RELAXED, __HIP_MEMORY_SCOPE_AGENT);
    while (__hip_atomic_load(cnt, __ATOMIC_RELAXED, __HIP_MEMORY_SCOPE_AGENT) < target) __builtin_amdgcn_s_sleep(2);
    __builtin_amdgcn_fence(__ATOMIC_ACQUIRE, "agent");
    asm volatile("s_waitcnt vmcnt(0)" ::: "memory");
  }
  __syncthreads();
}

template <int PH>
DI void run_phase(const Params& p, char* smem, int tid) {
  if (PH == 0) phase_prep(p, smem, tid);
  else if (PH == 1) phase_h(p, tid);
  else if (PH == 2) phase_inproj(p, smem, tid);
  else if (PH == 3) phase_diff(p, smem, tid);
  else if (PH == 4) phase_cmp2(p, smem, tid);
  else if (PH == 5) phase_nsa(p, smem, tid);
  else if (PH == 6) phase_branch(p, smem, tid);
  else if (PH == 7) phase_outproj(p, smem, tid);
  else phase_final(p, tid);
}

#if MULTI
template <int PH>
__global__ __launch_bounds__(NTHR) void phase_kernel(Params p) {
  extern __shared__ __attribute__((aligned(16))) char smem[];
  run_phase<PH>(p, smem, threadIdx.x);
}
#else
__global__ __launch_bounds__(NTHR) void mega_kernel(Params p) {
  extern __shared__ __attribute__((aligned(16))) char smem[];
  cg::grid_group grid = cg::this_grid();
  int* bar = p.ctr + 16;
  const int G = (int)gridDim.x;
  if (blockIdx.x == 0 && threadIdx.x == 0) __hip_atomic_store(bar, 0, __ATOMIC_RELAXED, __HIP_MEMORY_SCOPE_AGENT);
  { int t = threadIdx.x; asm volatile("" : "+v"(t)); run_phase<0>(p, smem, t); } grid.sync();
  { int t = threadIdx.x; asm volatile("" : "+v"(t)); run_phase<1>(p, smem, t); } grid_bar(bar, 1 * G);
  { int t = threadIdx.x; asm volatile("" : "+v"(t)); run_phase<2>(p, smem, t); } grid_bar(bar, 2 * G);
  { int t = threadIdx.x; asm volatile("" : "+v"(t)); run_phase<3>(p, smem, t); } grid_bar(bar, 3 * G);
  { int t = threadIdx.x; asm volatile("" : "+v"(t)); run_phase<4>(p, smem, t); } grid_bar(bar, 4 * G);
  { int t = threadIdx.x; asm volatile("" : "+v"(t)); run_phase<5>(p, smem, t); } grid_bar(bar, 5 * G);
  { int t = threadIdx.x; asm volatile("" : "+v"(t)); run_phase<6>(p, smem, t); } grid_bar(bar, 6 * G);
  { int t = threadIdx.x; asm volatile("" : "+v"(t)); run_phase<7>(p, smem, t); } grid_bar(bar, 7 * G);
  { int t = threadIdx.x; asm volatile("" : "+v"(t)); run_phase<8>(p, smem, t); }
}
#endif

static size_t alignup(size_t v) { return (v + 255) & ~(size_t)255; }

extern "C" void kernel_launch(void* const* d_in, const int* in_sizes, int n_in, void* d_out, int out_size, void* d_ws,
                              size_t ws_size, hipStream_t stream) {
  Params p{};
  const float** f = (const float**)&p;
  for (int i = 0; i < 20; ++i) f[i] = (const float*)d_in[i];
  p.out = (float*)d_out;
  char* w = (char*)d_ws;
  size_t off = 0;
  auto take = [&](size_t bytes) { char* r = w + off; off = alignup(off + bytes); return r; };
  p.WtIn = (u16*)take((size_t)NWP * DM * 2);
  p.WbT = (u16*)take((size_t)DM * DM * 2);
  p.WoT = (u16*)take((size_t)DM * DM * 2);
  p.W1T = (u16*)take((size_t)2 * 256 * 4096 * 2);
  p.W2T = (u16*)take((size_t)2 * 128 * 256 * 2);
  p.H = (u16*)take((size_t)TT * DM * 2);
  p.Qa = (u16*)take((size_t)TT * 1024 * 2);
  p.Ka = (u16*)take((size_t)TT * 1024 * 2);
  p.VaT = (u16*)take((size_t)TT * 1024 * 2);
  p.Za = (u16*)take((size_t)TT * 1024 * 2);
  p.Qb = (u16*)take((size_t)TT * 1024 * 2);
  p.KcR = (u16*)take((size_t)TT * 256 * 2);
  p.VcR = (u16*)take((size_t)TT * 256 * 2);
  p.Ks = (u16*)take((size_t)TT * 256 * 2);
  p.VsT = (u16*)take((size_t)TT * 256 * 2);
  p.Kw = (u16*)take((size_t)TT * 256 * 2);
  p.VwT = (u16*)take((size_t)TT * 256 * 2);
  p.Zb = (u16*)take((size_t)TT * 1024 * 2);
  p.Mg = (u16*)take((size_t)TT * 4096 * 2);
  p.Hc = (u16*)take((size_t)2 * 4096 * 256 * 2);
  p.Kc = (u16*)take((size_t)8 * 512 * 128 * 2);
  p.VcT = (u16*)take((size_t)8 * 128 * 512 * 2);
  p.Bg = (float*)take((size_t)TT * 24 * 4);
  p.mod = (float*)take((size_t)NB * 6144 * 4);
  p.cvec = (float*)take(512 * 4);
  p.tabA = (float2*)take((size_t)SQ * 8 * 8);
  p.tabB = (float2*)take((size_t)SQ * 16 * 8);
  p.ctr = (int*)take(256);
  p.Merged = p.Qa;
  if (off > ws_size) { fprintf(stderr, "workspace too small: need %zu have %zu\n", off, ws_size); return; }

  static int grid_blocks = 0;
#if MULTI
  if (!grid_blocks) {
    hipFuncSetAttribute((const void*)phase_kernel<0>, hipFuncAttributeMaxDynamicSharedMemorySize, SMEM_BYTES);
    hipFuncSetAttribute((const void*)phase_kernel<1>, hipFuncAttributeMaxDynamicSharedMemorySize, SMEM_BYTES);
    hipFuncSetAttribute((const void*)phase_kernel<2>, hipFuncAttributeMaxDynamicSharedMemorySize, SMEM_BYTES);
    hipFuncSetAttribute((const void*)phase_kernel<3>, hipFuncAttributeMaxDynamicSharedMemorySize, SMEM_BYTES);
    hipFuncSetAttribute((const void*)phase_kernel<4>, hipFuncAttributeMaxDynamicSharedMemorySize, SMEM_BYTES);
    hipFuncSetAttribute((const void*)phase_kernel<5>, hipFuncAttributeMaxDynamicSharedMemorySize, SMEM_BYTES);
    hipFuncSetAttribute((const void*)phase_kernel<6>, hipFuncAttributeMaxDynamicSharedMemorySize, SMEM_BYTES);
    hipFuncSetAttribute((const void*)phase_kernel<7>, hipFuncAttributeMaxDynamicSharedMemorySize, SMEM_BYTES);
    hipFuncSetAttribute((const void*)phase_kernel<8>, hipFuncAttributeMaxDynamicSharedMemorySize, SMEM_BYTES);
    grid_blocks = 256;
  }
  phase_kernel<0><<<grid_blocks, NTHR, SMEM_BYTES, stream>>>(p);
  phase_kernel<1><<<grid_blocks, NTHR, SMEM_BYTES, stream>>>(p);
  phase_kernel<2><<<grid_blocks, NTHR, SMEM_BYTES, stream>>>(p);
  phase_kernel<3><<<grid_blocks, NTHR, SMEM_BYTES, stream>>>(p);
  phase_kernel<4><<<grid_blocks, NTHR, SMEM_BYTES, stream>>>(p);
  phase_kernel<5><<<grid_blocks, NTHR, SMEM_BYTES, stream>>>(p);
  phase_kernel<6><<<grid_blocks, NTHR, SMEM_BYTES, stream>>>(p);
  phase_kernel<7><<<grid_blocks, NTHR, SMEM_BYTES, stream>>>(p);
  phase_kernel<8><<<grid_blocks, NTHR, SMEM_BYTES, stream>>>(p);
#else
  if (!grid_blocks) {
    int dev = 0, cus = 0, per_cu = 0;
    hipGetDevice(&dev);
    hipDeviceGetAttribute(&cus, hipDeviceAttributeMultiprocessorCount, dev);
    hipFuncSetAttribute((const void*)mega_kernel, hipFuncAttributeMaxDynamicSharedMemorySize, SMEM_BYTES);
    hipOccupancyMaxActiveBlocksPerMultiprocessor(&per_cu, (const void*)mega_kernel, NTHR, SMEM_BYTES);
    if (per_cu < 1) per_cu = 1;
    grid_blocks = cus * per_cu;
    grid_blocks -= grid_blocks % 64;
    if (grid_blocks < 64) grid_blocks = 64;
  }
  void* args[] = {&p};
  hipError_t e = hipLaunchCooperativeKernel((const void*)mega_kernel, dim3(grid_blocks), dim3(NTHR), args, SMEM_BYTES, stream);
  if (e != hipSuccess) fprintf(stderr, "cooperative launch failed: %s (grid %d)\n", hipGetErrorString(e), grid_blocks);
#endif
}
```

```cpp
#include <hip/hip_runtime.h>
#include <hip/hip_cooperative_groups.h>
#include <stdint.h>
#include <stdio.h>
namespace cg = cooperative_groups;

#ifndef MULTI
#define MULTI 0
#endif

#define DI static __device__ __forceinline__
typedef unsigned short u16;
typedef __attribute__((ext_vector_type(8))) short bf16x8;
typedef __attribute__((ext_vector_type(4))) float f32x4;
typedef __attribute__((ext_vector_type(4))) unsigned u32x4;

constexpr int NTHR = 512;
constexpr int DM = 2048, NB = 4, SQ = 8192, TT = NB * SQ;
constexpr int NWP = 12032;
constexpr int SMEM_BYTES = 149504;
constexpr float LOG2E = 1.4426950408889634f;
constexpr float EPSN = 1e-6f;

struct Params {
  const float *x, *c, *w_ada, *b_ada, *norm_g, *w_in, *lq1, *lk1, *lq2, *lk2, *diff_g, *pe_k, *pe_v,
      *w1k, *w2k, *w1v, *w2v, *w_branch, *w_out, *fin_g;
  float* out;
  u16 *WtIn, *WbT, *WoT, *W1T, *W2T, *H, *Qa, *Ka, *VaT, *Za, *Qb, *KcR, *VcR, *Ks, *VsT, *Kw, *VwT, *Zb, *Mg,
      *Hc, *Kc, *VcT, *Merged;
  float *Bg, *mod, *cvec;
  float2 *tabA, *tabB;
  int* ctr;
};

typedef __attribute__((ext_vector_type(2))) float f32x2;
typedef __attribute__((ext_vector_type(2))) __bf16 bf16x2_t;
DI unsigned pk2(float a, float b) { f32x2 v = {a, b}; bf16x2_t r = __builtin_convertvector(v, bf16x2_t); return __builtin_bit_cast(unsigned, r); }
DI u16 f2bf(float x) { return (u16)(pk2(x, 0.f) & 0xffffu); }
DI float bflo(unsigned w) { return __uint_as_float(w << 16); }
DI float bfhi(unsigned w) { return __uint_as_float(w & 0xffff0000u); }
DI float ex2(float x) { return __builtin_amdgcn_exp2f(x); }
DI float silu_f(float x) { return x * __builtin_amdgcn_rcpf(1.f + ex2(-LOG2E * x)); }
DI float sigm_f(float x) { return __builtin_amdgcn_rcpf(1.f + ex2(-LOG2E * x)); }
DI f32x4 mfma16(bf16x8 a, bf16x8 b, f32x4 c) { return __builtin_amdgcn_mfma_f32_16x16x32_bf16(a, b, c, 0, 0, 0); }
DI bf16x8 mk8(unsigned a, unsigned b, unsigned c, unsigned d) { u32x4 v = {a, b, c, d}; return __builtin_bit_cast(bf16x8, v); }
DI float wave_sum(float v) {
#pragma unroll
  for (int o = 32; o > 0; o >>= 1) v += __shfl_xor(v, o);
  return v;
}
DI float rowmax4(float x) {
  unsigned u = __float_as_uint(x);
  auto r = __builtin_amdgcn_permlane16_swap(u, u, false, false);
  x = fmaxf(__uint_as_float(r[0]), __uint_as_float(r[1]));
  u = __float_as_uint(x);
  auto q = __builtin_amdgcn_permlane32_swap(u, u, false, false);
  return fmaxf(__uint_as_float(q[0]), __uint_as_float(q[1]));
}
DI f32x4 zero4() { f32x4 z = {0.f, 0.f, 0.f, 0.f}; return z; }

template <class KO>
DI void gemm_main(f32x4 (&acc)[4][4], const u16* (&ap)[4], KO koff, const u16* (&bp)[2], int nk, char* smem, int tid) {
  const int lane = tid & 63, wid = tid >> 6, wm = wid >> 1, wn = wid & 1;
  const int lr = lane & 15, quad = lane >> 4;
  const int c = tid & 7, r = tid >> 3;
  const int woff = r * 128 + ((c ^ (r & 7)) << 4);
  char* As = smem;
  char* Bs = smem + 65536;
  uint4 ra[4], rb[2];
  __syncthreads();
  {
    long ko = koff(0);
#pragma unroll
    for (int i = 0; i < 4; ++i) ra[i] = *(const uint4*)(ap[i] + ko);
#pragma unroll
    for (int i = 0; i < 2; ++i) rb[i] = *(const uint4*)(bp[i]);
#pragma unroll
    for (int i = 0; i < 4; ++i) *(uint4*)(As + woff + i * 8192) = ra[i];
#pragma unroll
    for (int i = 0; i < 2; ++i) *(uint4*)(Bs + woff + i * 8192) = rb[i];
  }
  __syncthreads();
  for (int kt = 0; kt < nk; ++kt) {
    const int cur = kt & 1;
    if (kt + 1 < nk) {
      long ko = koff(kt + 1);
#pragma unroll
      for (int i = 0; i < 4; ++i) ra[i] = *(const uint4*)(ap[i] + ko);
#pragma unroll
      for (int i = 0; i < 2; ++i) rb[i] = *(const uint4*)(bp[i] + (size_t)(kt + 1) * 64);
    }
    const char* Ab = As + cur * 32768 + (wm * 64 + lr) * 128;
    const char* Bb = Bs + cur * 16384 + (wn * 64 + lr) * 128;
#pragma unroll
    for (int kk = 0; kk < 2; ++kk) {
      const int sw = ((kk * 4 + quad) ^ (lr & 7)) << 4;
      bf16x8 af[4], bfr[4];
#pragma unroll
      for (int mt = 0; mt < 4; ++mt) af[mt] = *(const bf16x8*)(Ab + mt * 2048 + sw);
#pragma unroll
      for (int nt = 0; nt < 4; ++nt) bfr[nt] = *(const bf16x8*)(Bb + nt * 2048 + sw);
#pragma unroll
      for (int mt = 0; mt < 4; ++mt)
#pragma unroll
        for (int nt = 0; nt < 4; ++nt) acc[mt][nt] = mfma16(af[mt], bfr[nt], acc[mt][nt]);
    }
    if (kt + 1 < nk) {
      const int nx = cur ^ 1;
#pragma unroll
      for (int i = 0; i < 4; ++i) *(uint4*)(As + nx * 32768 + woff + i * 8192) = ra[i];
#pragma unroll
      for (int i = 0; i < 2; ++i) *(uint4*)(Bs + nx * 16384 + woff + i * 8192) = rb[i];
    }
    __syncthreads();
  }
}

DI bool tile_map(int it, int nbm, int nbn, int& tm, int& tn, bool& valid) {
  const int xcd = blockIdx.x & 7, local = blockIdx.x >> 3, per = gridDim.x >> 3;
  const int SN = per >> 3;
  const int nsn = (nbn + SN - 1) / SN, nsm = nbm >> 3;
  const int st = it * 8 + xcd;
  if (st >= nsm * nsn) return false;
  const int sm_ = st / nsn, sn_ = st - sm_ * nsn;
  tm = sm_ * 8 + (local & 7);
  tn = sn_ * SN + (local >> 3);
  valid = tn < nbn;
  return true;
}

template <class FN>
DI void epi_pairs(const f32x4 (&acc)[4][4], int row0, int col0, int lane, FN fn) {
  const int lr = lane & 15, quad = lane >> 4;
  const bool odd = lane & 1;
#pragma unroll
  for (int mt = 0; mt < 4; ++mt)
#pragma unroll
    for (int nt = 0; nt < 4; ++nt) {
      f32x4 v = acc[mt][nt];
      float s0 = odd ? v[0] : v[1], s1 = odd ? v[2] : v[3];
      float r0 = __shfl_xor(s0, 1), r1 = __shfl_xor(s1, 1);
      float a0 = odd ? r0 : v[0], a1 = odd ? v[1] : r0;
      float b0 = odd ? r1 : v[2], b1 = odd ? v[3] : r1;
      int rr = row0 + mt * 16 + quad * 4 + (odd ? 1 : 0);
      int cc = col0 + nt * 16 + (lr & ~1);
      fn(rr, cc, a0, a1);
      fn(rr + 2, cc, b0, b1);
    }
}
DI void store_rm(const f32x4 (&acc)[4][4], u16* dst, int ld, int row0, int col0, int lane) {
  epi_pairs(acc, row0, col0, lane, [&](int rr, int cc, float x, float y) __attribute__((always_inline)) {
    *(unsigned*)(dst + (size_t)rr * ld + cc) = pk2(x, y);
  });
}
DI void store_tr(const f32x4 (&acc)[4][4], u16* dstT, int row0  , int lane) {
  const int lr = lane & 15, quad = lane >> 4;
#pragma unroll
  for (int mt = 0; mt < 4; ++mt)
#pragma unroll
    for (int nt = 0; nt < 4; ++nt) {
      f32x4 v = acc[mt][nt];
      uint2 w = {pk2(v[0], v[1]), pk2(v[2], v[3])};
      *(uint2*)(dstT + (size_t)(nt * 16 + lr) * SQ + row0 + mt * 16 + quad * 4) = w;
    }
}

DI void transpose_item(const float* src, int ldsrc, int nsrc0, int nvalid, int k0, u16* dst, int lddst, int n0,
                       char* smem, int tid) {
  float* tile = (float*)smem;
  __syncthreads();
#pragma unroll
  for (int i = 0; i < 2; ++i) {
    int id = tid + NTHR * i, k = id >> 4, c4 = id & 15;
    float4 v = make_float4(0.f, 0.f, 0.f, 0.f);
    if (c4 * 4 < nvalid) v = *(const float4*)(src + (size_t)(k0 + k) * ldsrc + nsrc0 + c4 * 4);
    float* t = tile + k * 65 + c4 * 4;
    t[0] = v.x; t[1] = v.y; t[2] = v.z; t[3] = v.w;
  }
  __syncthreads();
  {
    int n = tid >> 3, kc = tid & 7;
    const float* t = tile + (kc * 8) * 65 + n;
    uint4 w;
    w.x = pk2(t[0], t[65]); w.y = pk2(t[130], t[195]); w.z = pk2(t[260], t[325]); w.w = pk2(t[390], t[455]);
    *(uint4*)(dst + (size_t)(n0 + n) * lddst + k0 + kc * 8) = w;
  }
}

DI void phase_prep(const Params& p, char* smem, int tid) {
  constexpr int N_WIN = 32 * 188, N_WB = 1024, N_WO = 1024, N_W1 = 256, N_W2 = 8;
  constexpr int O_WB = N_WIN, O_WO = O_WB + N_WB, O_W1K = O_WO + N_WO, O_W1V = O_W1K + N_W1, O_W2K = O_W1V + N_W1,
                O_W2V = O_W2K + N_W2, O_MOD = O_W2V + N_W2, O_CV = O_MOD + 96, O_TAB = O_CV + 8, O_END = O_TAB + 32;
  for (int it = blockIdx.x; it < O_END; it += gridDim.x) {
    if (it < O_WB) {
      int kt = it & 31, nt = it >> 5, n0 = nt * 64, src0, nv;
      if (n0 < 7680) { src0 = n0; nv = 64; }
      else if (n0 < 11776) { src0 = n0 + 24; nv = 64; }
      else if (n0 == 11776) { src0 = 7680; nv = 24; }
      else { src0 = 0; nv = 0; }
      transpose_item(p.w_in, 11800, src0, nv, kt * 64, p.WtIn, DM, n0, smem, tid);
    } else if (it < O_WO) {
      int i = it - O_WB; transpose_item(p.w_branch, DM, (i >> 5) * 64, 64, (i & 31) * 64, p.WbT, DM, (i >> 5) * 64, smem, tid);
    } else if (it < O_W1K) {
      int i = it - O_WO; transpose_item(p.w_out, DM, (i >> 5) * 64, 64, (i & 31) * 64, p.WoT, DM, (i >> 5) * 64, smem, tid);
    } else if (it < O_W2K) {
      int i = it - O_W1K; int kv = i >> 8; i &= 255;
      transpose_item(kv ? p.w1v : p.w1k, 256, (i >> 6) * 64, 64, (i & 63) * 64, p.W1T + (size_t)kv * 256 * 4096, 4096, (i >> 6) * 64, smem, tid);
    } else if (it < O_MOD) {
      int i = it - O_W2K; int kv = i >> 3; i &= 7;
      transpose_item(kv ? p.w2v : p.w2k, 128, (i >> 2) * 64, 64, (i & 3) * 64, p.W2T + (size_t)kv * 128 * 256, 256, (i >> 2) * 64, smem, tid);
    } else if (it < O_CV) {
      int col0 = (it - O_MOD) * 64;
      float* sc = (float*)smem;
      float* red = (float*)(smem + 32768);
      __syncthreads();
      for (int i = tid; i < NB * DM; i += NTHR) sc[i] = silu_f(p.c[i]);
      __syncthreads();
      int col = tid & 63, kg = tid >> 6;
      float a0 = 0, a1 = 0, a2 = 0, a3 = 0;
      for (int k = kg * 256; k < kg * 256 + 256; ++k) {
        float w = p.w_ada[(size_t)k * 6144 + col0 + col];
        a0 += sc[k] * w; a1 += sc[DM + k] * w; a2 += sc[2 * DM + k] * w; a3 += sc[3 * DM + k] * w;
      }
      red[(kg * 4 + 0) * 64 + col] = a0; red[(kg * 4 + 1) * 64 + col] = a1;
      red[(kg * 4 + 2) * 64 + col] = a2; red[(kg * 4 + 3) * 64 + col] = a3;
      __syncthreads();
      if (tid < 256) {
        int b = tid >> 6, cc = tid & 63; float s = 0;
#pragma unroll
        for (int g = 0; g < 8; ++g) s += red[(g * 4 + b) * 64 + cc];
        p.mod[b * 6144 + col0 + cc] = s + p.b_ada[col0 + cc];
      }
    } else if (it < O_TAB) {
      int i = it - O_CV, kv = i >> 2, col0 = (i & 3) * 64;
      const float* pe = kv ? p.pe_v : p.pe_k; const float* w1 = kv ? p.w1v : p.w1k;
      float* red = (float*)smem;
      __syncthreads();
      int col = tid & 63, kg = tid >> 6; float a = 0;
      for (int k = kg * 512; k < kg * 512 + 512; ++k) a += pe[k] * w1[(size_t)k * 256 + col0 + col];
      red[kg * 64 + col] = a;
      __syncthreads();
      if (tid < 64) { float s = 0;
#pragma unroll
        for (int g = 0; g < 8; ++g) s += red[g * 64 + tid];
        p.cvec[kv * 256 + col0 + tid] = s; }
    } else {
      int i = it - O_TAB;
      if (i == 0 && tid == 0) { p.ctr[0] = 0; p.ctr[1] = 0; }
      if (tid < 256) {
        int pos = i * 256 + tid;
        for (int fi = 0; fi < 24; ++fi) {
          double ex = (fi < 16) ? (double)fi * (2.0 / 32.0) : (double)(fi - 16) * (2.0 / 16.0);
          float inv = (float)(1.0 / exp2(ex * 18.931568569324174));
          float ang = (float)pos * inv;
          double rev = (double)ang * 0.15915494309189535;
          rev -= rint(rev);
          float fr = (float)rev;
          float2 cs = make_float2(__builtin_amdgcn_cosf(fr), __builtin_amdgcn_sinf(fr));
          if (fi < 16) p.tabB[pos * 16 + fi] = cs; else p.tabA[pos * 8 + (fi - 16)] = cs;
        }
      }
      if (i == 1) {
        for (int e = tid; e < 8 * 128; e += NTHR) {
          int bg = e >> 7, d = e & 127;
          p.Kc[((size_t)bg * 512 + 511) * 128 + d] = 0;
          p.VcT[((size_t)bg * 128 + d) * 512 + 511] = 0;
        }
      }
    }
  }
}

DI void phase_h(const Params& p, int tid) {
  const int lane = tid & 63, wid = tid >> 6;
  for (int it = blockIdx.x; it < TT / 16; it += gridDim.x) {
#pragma unroll 1
    for (int rr = 0; rr < 2; ++rr) {
      int row = it * 16 + wid * 2 + rr, b = row >> 13;
      const float4* xr = (const float4*)(p.x + (size_t)row * DM);
      float4 v[8]; float ss = 0;
#pragma unroll
      for (int i = 0; i < 8; ++i) { v[i] = xr[lane + 64 * i]; ss += v[i].x * v[i].x + v[i].y * v[i].y + v[i].z * v[i].z + v[i].w * v[i].w; }
      ss = wave_sum(ss);
      float rs = rsqrtf(ss * (1.f / DM) + EPSN);
      const float4* g4 = (const float4*)p.norm_g;
      const float4* sh4 = (const float4*)(p.mod + b * 6144);
      const float4* sc4 = (const float4*)(p.mod + b * 6144 + DM);
#pragma unroll
      for (int i = 0; i < 8; ++i) {
        int c4 = lane + 64 * i; float4 g = g4[c4], sh = sh4[c4], sc = sc4[c4];
        float o0 = v[i].x * rs * g.x * (1.f + sc.x) + sh.x, o1 = v[i].y * rs * g.y * (1.f + sc.y) + sh.y;
        float o2 = v[i].z * rs * g.z * (1.f + sc.z) + sh.z, o3 = v[i].w * rs * g.w * (1.f + sc.w) + sh.w;
        uint2 w = {pk2(o0, o1), pk2(o2, o3)};
        *(uint2*)(p.H + (size_t)row * DM + c4 * 4) = w;
      }
    }
  }
}

namespace g8 {
#define G8_LAS __attribute__((address_space(3)))
constexpr int BK = 64, HALF = 128, HTB = HALF * BK * 2;
DI int lds_byte(int r, int c) { const int st = (r >> 4) * 2 + (c >> 5), rr = r & 15, cc = c & 31, ob = rr * 64 + cc * 2; return st * 1024 + (ob ^ (((ob >> 9) & 1) << 5)); }
DI void stage_rc(int b, int& R, int& C) { const int st = b / 1024, sb = b % 1024, swz = sb ^ (((sb >> 9) & 1) << 5); R = (st >> 1) * 16 + swz / 64; C = (st & 1) * 32 + (swz % 64) / 2; }
DI int perm32(int rho) { const int n = rho >> 4, i = rho & 15; return 8 * (i >> 2) + 4 * n + (i & 3); }
struct Unit { const char* a; const char* b; int pm, pn, kind; };
DI bool order_next(int i, int G, int c, int nM, int nN, int& pm, int& pn) {
  const int nwg = nM * nN;
  const long L = (long)i * G + c; if (L >= nwg) return false;
  int wgid = (int)L; { const int q = nwg / 8, r = nwg % 8, xcd = wgid % 8, off = wgid / 8; wgid = (xcd < r ? xcd * (q + 1) : r * (q + 1) + (xcd - r) * q) + off; }
  const int nig = 8 * nN, gid = wgid / nig, fm = gid * 8, gsz = (nM - fm) < 8 ? (nM - fm) : 8;
  pm = fm + ((wgid % nig) % gsz); pn = (wgid % nig) / gsz; return true;
}

template <int LD, class Sched, class Epi>
DI void gemm_phase(G8_LAS unsigned char* lds, const int K, const Sched& S, const Epi& E) {
  const int tid = threadIdx.x, wid = __builtin_amdgcn_readfirstlane(tid >> 6), lane = tid & 63, wr = wid >> 2, wc = wid & 3, fr = lane & 15, fq = lane >> 4;
  const int nt = K / BK;
  unsigned voffA[2], voffB[2];
#pragma unroll
  for (int i = 0; i < 2; ++i) { int R, C; stage_rc(tid * 16 + i * 8192, R, C); const int Rb = (R & ~31) + perm32(R & 31);
    voffA[i] = (unsigned)(R * LD + C) * 2u; voffB[i] = (unsigned)(Rb * LD + C) * 2u; }
  const size_t kstep = (size_t)(BK * 2);
  const size_t hstep = (size_t)HALF * LD * 2;
  const unsigned ldsw = (unsigned)wid * 1024u;
  const int aoff = lds_byte(wr * 64 + fr, fq * 8), boff = lds_byte(wc * 32 + fr, fq * 8);
#define G8_SA(b, h) (((b) * 2 + (h)) * HTB)
#define G8_SB(b, h) ((4 + (b) * 2 + (h)) * HTB)
#define G8_STAGE(bufoff, gbase, voff) do { _Pragma("unroll") for (int _i = 0; _i < 2; ++_i) \
    __builtin_amdgcn_global_load_lds((const unsigned*)((const char*)(gbase) + (voff)[_i]), (G8_LAS unsigned*)(lds + (bufoff) + ldsw + _i * 8192), 16, 0, 0); } while (0)
#define G8_LDA(dst, b, h) do { _Pragma("unroll") for (int m = 0; m < 4; ++m) _Pragma("unroll") for (int k = 0; k < 2; ++k) dst[m][k] = *(const G8_LAS bf16x8*)(lds + G8_SA(b, h) + aoff + m * 2048 + k * 1024); } while (0)
#define G8_LDB(dst, b, h) do { _Pragma("unroll") for (int n = 0; n < 2; ++n) _Pragma("unroll") for (int k = 0; k < 2; ++k) dst[n][k] = *(const G8_LAS bf16x8*)(lds + G8_SB(b, h) + boff + n * 2048 + k * 1024); } while (0)
#define G8_MMA(ai, bj, At, Bt) do { __builtin_amdgcn_s_setprio(1); _Pragma("unroll") for (int m = 0; m < 4; ++m) _Pragma("unroll") for (int n = 0; n < 2; ++n) _Pragma("unroll") for (int k = 0; k < 2; ++k) \
    acc[ai][bj][m][n] = __builtin_amdgcn_mfma_f32_16x16x32_bf16(Bt[n][k], At[m][k], acc[ai][bj][m][n], 0, 0, 0); __builtin_amdgcn_s_setprio(0); } while (0)
#define G8_WAIT_V(n) asm volatile("s_waitcnt vmcnt(" #n ")" ::: "memory")
#define G8_WAIT_L(n) asm volatile("s_waitcnt lgkmcnt(" #n ")" ::: "memory")
#define G8_BAR __builtin_amdgcn_s_barrier()
#define G8_SCHED __builtin_amdgcn_sched_barrier(0)
  Unit cur, nxt; int ui = 0;
  if (!S.next(0, cur)) return;
  f32x4 acc[2][2][4][2];
#pragma unroll
  for (int a = 0; a < 2; ++a)
#pragma unroll
    for (int b = 0; b < 2; ++b)
#pragma unroll
      for (int m = 0; m < 4; ++m)
#pragma unroll
        for (int n = 0; n < 2; ++n) acc[a][b][m][n] = zero4();
  bf16x8 At[4][2], B0[2][2], B1[2][2];
  const char* cA = cur.a; const char* cB = cur.b;
  G8_STAGE(G8_SB(0, 0), cB, voffB); G8_STAGE(G8_SA(0, 0), cA, voffA); G8_STAGE(G8_SB(0, 1), cB + hstep, voffB); G8_STAGE(G8_SA(0, 1), cA + hstep, voffA);
  if (wr == 1) G8_BAR;
  G8_WAIT_V(4); G8_BAR;
  G8_STAGE(G8_SB(1, 0), cB + kstep, voffB); G8_STAGE(G8_SA(1, 0), cA + kstep, voffA); G8_STAGE(G8_SB(1, 1), cB + hstep + kstep, voffB);
  G8_WAIT_V(6); G8_BAR;
  for (;;) {
    const bool has_next = S.next(ui + 1, nxt);
    const char* nA = has_next ? nxt.a : cA; const char* nB = has_next ? nxt.b : cB;
    for (int t = 0; t < nt; t += 2) {
      const bool last = (t == nt - 2);
      const char* a1 = cA + (size_t)(t + 1) * kstep;
      const char* a2 = last ? nA : cA + (size_t)(t + 2) * kstep; const char* b2 = last ? nB : cB + (size_t)(t + 2) * kstep;
      const char* a3 = a2 + kstep; const char* b3 = b2 + kstep;
      G8_LDB(B0, 0, 0); G8_SCHED; G8_LDA(At, 0, 0); G8_STAGE(G8_SA(1, 1), a1 + hstep, voffA);
      G8_WAIT_L(8); G8_BAR; G8_WAIT_L(0); G8_MMA(0, 0, At, B0); G8_BAR; G8_SCHED;
      G8_LDB(B1, 0, 1); G8_STAGE(G8_SB(0, 0), b2, voffB);
      G8_BAR; G8_WAIT_L(0); G8_MMA(0, 1, At, B1); G8_BAR;
      G8_LDA(At, 0, 1); G8_STAGE(G8_SA(0, 0), a2, voffA);
      G8_BAR; G8_WAIT_L(0); G8_MMA(1, 0, At, B0); G8_BAR; G8_SCHED;
      G8_STAGE(G8_SB(0, 1), b2 + hstep, voffB);
      G8_WAIT_V(6); G8_BAR; G8_MMA(1, 1, At, B1); G8_BAR;
      G8_LDB(B0, 1, 0); G8_SCHED; G8_LDA(At, 1, 0); G8_STAGE(G8_SA(0, 1), a2 + hstep, voffA);
      G8_WAIT_L(8); G8_BAR; G8_WAIT_L(0); G8_MMA(0, 0, At, B0); G8_BAR; G8_SCHED;
      G8_LDB(B1, 1, 1); G8_STAGE(G8_SB(1, 0), b3, voffB);
      G8_BAR; G8_WAIT_L(0); G8_MMA(0, 1, At, B1); G8_BAR;
      G8_LDA(At, 1, 1); G8_STAGE(G8_SA(1, 0), a3, voffA);
      G8_BAR; G8_WAIT_L(0); G8_MMA(1, 0, At, B0); G8_BAR; G8_SCHED;
      G8_STAGE(G8_SB(1, 1), b3 + hstep, voffB);
      G8_WAIT_V(6); G8_BAR; G8_MMA(1, 1, At, B1); G8_BAR;
    }
    E(acc, cur, wr, wc, fr, fq);
    if (!has_next) break;
#pragma unroll
    for (int a = 0; a < 2; ++a)
#pragma unroll
      for (int b = 0; b < 2; ++b)
#pragma unroll
        for (int m = 0; m < 4; ++m)
#pragma unroll
          for (int n = 0; n < 2; ++n) acc[a][b][m][n] = zero4();
    cur = nxt; cA = nA; cB = nB; ++ui;
  }
  G8_WAIT_V(0);
  if (wr == 0) G8_BAR;
  G8_BAR;
#undef G8_SA
#undef G8_SB
#undef G8_STAGE
#undef G8_LDA
#undef G8_LDB
#undef G8_MMA
#undef G8_WAIT_V
#undef G8_WAIT_L
#undef G8_BAR
#undef G8_SCHED
}
}

DI uint4 pack8(f32x4 a, f32x4 b) { uint4 w; w.x = pk2(a[0], a[1]); w.y = pk2(a[2], a[3]); w.z = pk2(b[0], b[1]); w.w = pk2(b[2], b[3]); return w; }
DI void unpack8(uint4 w, f32x4& a, f32x4& b) { a[0] = bflo(w.x); a[1] = bfhi(w.x); a[2] = bflo(w.y); a[3] = bfhi(w.y); b[0] = bflo(w.z); b[1] = bfhi(w.z); b[2] = bflo(w.w); b[3] = bfhi(w.w); }

struct InprojSched {
  const u16* H; const u16* W; int G, c;
  __device__ __forceinline__ bool next(int i, g8::Unit& u) const {
    int pm, pn;
    if (!g8::order_next(i, G, c, TT / 256, NWP / 256, pm, pn)) return false;
    u.pm = pm; u.pn = pn;
    const bool sw = (pn >= 8 && pn < 12) || pn == 23 || pn == 25;
    u.kind = sw ? 1 : 0;
    const char* hp = (const char*)(H + (size_t)pm * 256 * DM); const char* wp = (const char*)(W + (size_t)pn * 256 * DM);
    u.a = sw ? wp : hp; u.b = sw ? hp : wp;
    return true;
  }
};
struct InprojEpi {
  const Params* pp;
  __device__ __forceinline__ void operator()(const f32x4 (&acc)[2][2][4][2], const g8::Unit& u, int wr, int wc, int fr, int fq) const {
    const Params& p = *pp;
    const int pn = u.pn, m0 = u.pm * 256, n0 = pn * 256, b = m0 >> 13;
    const int cb = 32 * wc + 8 * fq;
    if (u.kind) {
      u16* base; int f0, nf;
      if (pn < 12) { base = p.VaT; f0 = n0 - 2048; nf = 1024; }
      else if (pn == 23) { base = p.VsT; f0 = 0; nf = 256; }
      else { base = p.VwT; f0 = 0; nf = 256; }
      const int s0 = (m0 & (SQ - 1)) + 32 * wc + 16 * (fq & 1) + 4 * (fq >> 1);
#pragma unroll
      for (int ai = 0; ai < 2; ++ai)
#pragma unroll
        for (int m = 0; m < 4; ++m) {
          const int f = f0 + 128 * ai + 64 * wr + 16 * m + fr;
          u16* rowp = base + ((size_t)b * nf + f) * SQ + s0;
#pragma unroll
          for (int bj = 0; bj < 2; ++bj) {
            const f32x4 v0 = acc[ai][bj][m][0], v1 = acc[ai][bj][m][1];
            *(uint2*)(rowp + 128 * bj) = make_uint2(pk2(v0[0], v0[1]), pk2(v0[2], v0[3]));
            *(uint2*)(rowp + 128 * bj + 8) = make_uint2(pk2(v1[0], v1[1]), pk2(v1[2], v1[3]));
          }
        }
      return;
    }
    u16* dst; int ld, cbase, mode;
    if (pn < 4) { dst = p.Qa; ld = 1024; cbase = n0; mode = 4; }
    else if (pn < 8) { dst = p.Ka; ld = 1024; cbase = n0 - 1024; mode = 3; }
    else if (pn < 16) { dst = p.Za; ld = 1024; cbase = n0 - 3072; mode = 1; }
    else if (pn < 20) { dst = p.Qb; ld = 1024; cbase = n0 - 4096; mode = 5; }
    else if (pn == 20) { dst = p.KcR; ld = 256; cbase = 0; mode = 0; }
    else if (pn == 21) { dst = p.VcR; ld = 256; cbase = 0; mode = 0; }
    else if (pn == 22) { dst = p.Ks; ld = 256; cbase = 0; mode = 5; }
    else if (pn == 24) { dst = p.Kw; ld = 256; cbase = 0; mode = 5; }
    else if (pn < 30) { dst = p.Zb; ld = 1024; cbase = n0 - 6656; mode = 1; }
    else if (pn < 46) { dst = p.Mg; ld = 4096; cbase = n0 - 7680; mode = 2; }
    else { dst = nullptr; ld = 0; cbase = 0; mode = 6; }
#pragma unroll
    for (int ai = 0; ai < 2; ++ai)
#pragma unroll
      for (int m = 0; m < 4; ++m) {
        const int row = m0 + 128 * ai + 64 * wr + 16 * m + fr, s = row & (SQ - 1);
#pragma unroll
        for (int bj = 0; bj < 2; ++bj) {
          f32x4 v0 = acc[ai][bj][m][0], v1 = acc[ai][bj][m][1];
          if (mode == 3 || mode == 4) {
            if ((wc & 1) == 0) {
              const float4* t4 = (const float4*)(p.tabA + (size_t)s * 8);
              float4 ta = t4[0], tb = t4[1], tc = t4[2], td = t4[3];
              const float sg = (fq == 0) ? -1.f : 1.f;
              const bool act = fq < 2;
              f32x4 p0, p1;
#pragma unroll
              for (int j = 0; j < 4; ++j) { p0[j] = __shfl_xor(v0[j], 16); p1[j] = __shfl_xor(v1[j], 16); }
              if (act) {
                v0[0] = v0[0] * ta.x + sg * p0[0] * ta.y; v0[1] = v0[1] * ta.z + sg * p0[1] * ta.w;
                v0[2] = v0[2] * tb.x + sg * p0[2] * tb.y; v0[3] = v0[3] * tb.z + sg * p0[3] * tb.w;
                v1[0] = v1[0] * tc.x + sg * p1[0] * tc.y; v1[1] = v1[1] * tc.z + sg * p1[1] * tc.w;
                v1[2] = v1[2] * td.x + sg * p1[2] * td.y; v1[3] = v1[3] * td.z + sg * p1[3] * td.w;
              }
            }
            if (mode == 4) { v0 *= 0.125f; v1 *= 0.125f; }
          } else if (mode == 5) {
            if (wc == 0) {
              const float4* t4 = (const float4*)(p.tabB + (size_t)s * 16 + 8 * (fq & 1));
              float4 ta = t4[0], tb = t4[1], tc = t4[2], td = t4[3];
              const float sg = (fq < 2) ? -1.f : 1.f;
              f32x4 p0, p1;
#pragma unroll
              for (int j = 0; j < 4; ++j) { p0[j] = __shfl_xor(v0[j], 32); p1[j] = __shfl_xor(v1[j], 32); }
              v0[0] = v0[0] * ta.x + sg * p0[0] * ta.y; v0[1] = v0[1] * ta.z + sg * p0[1] * ta.w;
              v0[2] = v0[2] * tb.x + sg * p0[2] * tb.y; v0[3] = v0[3] * tb.z + sg * p0[3] * tb.w;
              v1[0] = v1[0] * tc.x + sg * p1[0] * tc.y; v1[1] = v1[1] * tc.z + sg * p1[1] * tc.w;
              v1[2] = v1[2] * td.x + sg * p1[2] * td.y; v1[3] = v1[3] * td.z + sg * p1[3] * td.w;
            }
          } else if (mode == 1) {
#pragma unroll
            for (int j = 0; j < 4; ++j) { v0[j] = silu_f(v0[j]); v1[j] = silu_f(v1[j]); }
          } else if (mode == 2 || mode == 6) {
#pragma unroll
            for (int j = 0; j < 4; ++j) { v0[j] = sigm_f(v0[j]); v1[j] = sigm_f(v1[j]); }
          }
          if (mode == 6) {
            if (bj == 0 && cb < 24) { float* bp = p.Bg + (size_t)row * 24 + cb; *(f32x4*)bp = v0; *(f32x4*)(bp + 4) = v1; }
          } else {
            { const uint4 w_ = pack8(v0, v1); u32x4 wv_ = {w_.x, w_.y, w_.z, w_.w};
              __builtin_nontemporal_store(wv_, (u32x4*)(dst + (size_t)row * ld + cbase + 128 * bj + cb)); }
          }
        }
      }
  }
};
DI void phase_inproj(const Params& p, char* smem, int tid) {
  InprojSched S{p.H, p.WtIn, (int)gridDim.x, (int)blockIdx.x};
  InprojEpi E{&p};
  g8::gemm_phase<DM>((G8_LAS unsigned char*)smem, DM, S, E);
}

struct BranchSched {
  const u16* Mix; const u16* W; int G, c;
  __device__ __forceinline__ bool next(int i, g8::Unit& u) const {
    const long L = (long)i * G + c;
    if (L >= 2048) return false;
    const int half = (int)(L >> 10);
    int pm, pn;
    g8::order_next(i & ((1024 / G) - 1), G, c, TT / 256, DM / 256, pm, pn);
    u.pm = pm; u.pn = pn; u.kind = half;
    u.a = (const char*)(Mix + (size_t)pm * 256 * DM + half * 1024);
    u.b = (const char*)(W + (size_t)pn * 256 * DM + half * 1024);
    return true;
  }
};
struct BranchEpi {
  const Params* pp;
  __device__ __forceinline__ void operator()(const f32x4 (&acc)[2][2][4][2], const g8::Unit& u, int wr, int wc, int fr, int fq) const {
    const Params& p = *pp;
    const int m0 = u.pm * 256, n0 = u.pn * 256, cb = 32 * wc + 8 * fq;
#pragma unroll
    for (int ai = 0; ai < 2; ++ai)
#pragma unroll
      for (int m = 0; m < 4; ++m) {
        const size_t row = (size_t)(m0 + 128 * ai + 64 * wr + 16 * m + fr);
#pragma unroll
        for (int bj = 0; bj < 2; ++bj) {
          const int col = n0 + 128 * bj + cb;
          f32x4 g0, g1;
          unpack8(*(const uint4*)(p.Mg + row * 4096 + u.kind * 2048 + col), g0, g1);
          f32x4 v0 = acc[ai][bj][m][0] * g0, v1 = acc[ai][bj][m][1] * g1;
          uint4* mp = (uint4*)(p.Merged + row * DM + col);
          if (u.kind) { f32x4 o0, o1; unpack8(*mp, o0, o1); v0 += o0; v1 += o1; }
          *mp = pack8(v0, v1);
        }
      }
  }
};
DI void phase_branch(const Params& p, char* smem, int tid) {
  BranchSched S{p.H, p.WbT, (int)gridDim.x, (int)blockIdx.x};
  BranchEpi E{&p};
  g8::gemm_phase<DM>((G8_LAS unsigned char*)smem, 1024, S, E);
}

struct OutSched {
  const u16* A; const u16* W; int G, c;
  __device__ __forceinline__ bool next(int i, g8::Unit& u) const {
    int pm, pn;
    if (!g8::order_next(i, G, c, TT / 256, DM / 256, pm, pn)) return false;
    u.pm = pm; u.pn = pn; u.kind = 0;
    u.a = (const char*)(A + (size_t)pm * 256 * DM); u.b = (const char*)(W + (size_t)pn * 256 * DM);
    return true;
  }
};
struct OutEpi {
  const Params* pp;
  __device__ __forceinline__ void operator()(const f32x4 (&acc)[2][2][4][2], const g8::Unit& u, int wr, int wc, int fr, int fq) const {
    const Params& p = *pp;
    const int m0 = u.pm * 256, n0 = u.pn * 256, cb = 32 * wc + 8 * fq, b = m0 >> 13;
#pragma unroll
    for (int bj = 0; bj < 2; ++bj) {
      const int col = n0 + 128 * bj + cb;
      const f32x4 ga = *(const f32x4*)(p.mod + b * 6144 + 4096 + col), gb = *(const f32x4*)(p.mod + b * 6144 + 4096 + col + 4);
#pragma unroll
      for (int ai = 0; ai < 2; ++ai)
#pragma unroll
        for (int m = 0; m < 4; ++m) {
          const size_t idx = (size_t)(m0 + 128 * ai + 64 * wr + 16 * m + fr) * DM + col;
          *(uint4*)(p.Za + idx) = pack8(ga * acc[ai][bj][m][0], gb * acc[ai][bj][m][1]);
        }
    }
  }
};
DI void phase_outproj(const Params& p, char* smem, int tid) {
  OutSched S{p.Merged, p.WoT, (int)gridDim.x, (int)blockIdx.x};
  OutEpi E{&p};
  g8::gemm_phase<DM>((G8_LAS unsigned char*)smem, DM, S, E);
}

DI void cmp1_tile(const Params& p, int it, char* smem, int tid) {
  const int lane = tid & 63, wid = tid >> 6, wm = wid >> 1, wn = wid & 1;
  const int c = tid & 7, r = tid >> 3;
  {
    const int kv = it >> 5, tm = (it >> 1) & 15, tn = it & 1;
    const int m0 = tm * 256, n0 = tn * 128;
    f32x4 acc[4][4];
#pragma unroll
    for (int i = 0; i < 4; ++i)
#pragma unroll
      for (int j = 0; j < 4; ++j) acc[i][j] = zero4();
    const u16* raw = kv ? p.VcR : p.KcR;
    const u16* ap[4]; const u16* bp[2];
#pragma unroll
    for (int i = 0; i < 4; ++i) {
      int rr = m0 + r + 64 * i; if (rr > 4087) rr = 4087;
      int b = rr / 1022, rem = rr - b * 1022, n = rem >> 1, g = rem & 1;
      ap[i] = raw + ((size_t)(b * SQ + n * 16)) * 256 + g * 128 + c * 8;
    }
#pragma unroll
    for (int i = 0; i < 2; ++i) bp[i] = p.W1T + (size_t)kv * 256 * 4096 + (size_t)(n0 + r + 64 * i) * 4096 + c * 8;
    gemm_main(acc, ap, [](int kt) __attribute__((always_inline)) { return (long)(kt >> 1) * 256 + (kt & 1) * 64; }, bp, 64, smem, tid);
    const int lr = lane & 15;
#pragma unroll
    for (int nt = 0; nt < 4; ++nt) {
      float cv = p.cvec[kv * 256 + n0 + wn * 64 + nt * 16 + lr];
#pragma unroll
      for (int mt = 0; mt < 4; ++mt)
#pragma unroll
        for (int i = 0; i < 4; ++i) acc[mt][nt][i] = silu_f(acc[mt][nt][i] + cv);
    }
    store_rm(acc, p.Hc + (size_t)kv * 4096 * 256, 256, m0 + wm * 64, n0 + wn * 64, lane);
  }
}

DI void phase_cmp2(const Params& p, char* smem, int tid) {
  const int lane = tid & 63, wid = tid >> 6, wm = wid >> 1, wn = wid & 1, lr = lane & 15, quad = lane >> 4;
  const int c = tid & 7, r = tid >> 3;
  for (int it = blockIdx.x; it < 32; it += gridDim.x) {
    const int kv = it >> 4, tm = it & 15, m0 = tm * 256;
    f32x4 acc[4][4];
#pragma unroll
    for (int i = 0; i < 4; ++i)
#pragma unroll
      for (int j = 0; j < 4; ++j) acc[i][j] = zero4();
    const u16* ap[4]; const u16* bp[2];
#pragma unroll
    for (int i = 0; i < 4; ++i) ap[i] = p.Hc + (size_t)kv * 4096 * 256 + (size_t)(m0 + r + 64 * i) * 256 + c * 8;
#pragma unroll
    for (int i = 0; i < 2; ++i) bp[i] = p.W2T + (size_t)kv * 128 * 256 + (size_t)(r + 64 * i) * 256 + c * 8;
    gemm_main(acc, ap, [](int kt) __attribute__((always_inline)) { return (long)kt * 64; }, bp, 4, smem, tid);
#pragma unroll
    for (int mt = 0; mt < 4; ++mt)
#pragma unroll
      for (int i = 0; i < 4; ++i) {
        int rr = m0 + wm * 64 + mt * 16 + quad * 4 + i;
        if (rr < 4088) {
          int b = rr / 1022, rem = rr - b * 1022, n = rem >> 1, g = rem & 1, bg = b * 2 + g;
          if (kv == 0) {
            float v0 = acc[mt][0][i], v1 = acc[mt][1][i];
            if (wn == 0) {
              float2 cs = p.tabB[(n * 16 + 31) * 16 + lr];
              float t0 = v0 * cs.x - v1 * cs.y, t1 = v1 * cs.x + v0 * cs.y; v0 = t0; v1 = t1;
            }
            u16* d = p.Kc + ((size_t)bg * 512 + n) * 128 + wn * 64 + lr;
            d[0] = f2bf(v0); d[16] = f2bf(v1); d[32] = f2bf(acc[mt][2][i]); d[48] = f2bf(acc[mt][3][i]);
          } else {
            const int u = n & 31, npos = (n & ~31) + ((u < 16) ? (8 * (u >> 2) + (u & 3)) : (8 * ((u - 16) >> 2) + 4 + (u & 3)));
#pragma unroll
            for (int nt = 0; nt < 4; ++nt)
              p.VcT[((size_t)bg * 128 + wn * 64 + nt * 16 + lr) * 512 + npos] = f2bf(acc[mt][nt][i]);
          }
        }
      }
  }
}

template <class F>
DI void kv_pipeline(int jlo, int jhi, const u16* kb, int ldk, const u16* vb, int ldv, char* smem, int tid, F&& body) {
  const int wid = __builtin_amdgcn_readfirstlane(tid >> 6), lane = tid & 63;
  unsigned ksrc[2], vsrc[2];
#pragma unroll
  for (int i = 0; i < 2; ++i) {
    const int row = (i * 8 + wid) * 4 + (lane >> 4), chunk = (lane & 15) ^ (row & 15);
    ksrc[i] = (unsigned)(row * ldk + chunk * 8) * 2u;
    const int d = (i * 8 + wid) * 8 + (lane >> 3), c16 = (lane & 7) ^ ((d >> 1) & 7);
    vsrc[i] = (unsigned)(d * ldv + c16 * 8) * 2u;
  }
  G8_LAS unsigned char* lds = (G8_LAS unsigned char*)smem;
  const unsigned ldsw = (unsigned)wid * 1024u;
#define KV_ISSUE(j, buf) do { const char* _kg = (const char*)(kb + (size_t)(j) * 64 * ldk); const char* _vg = (const char*)(vb + (size_t)(j) * 64); \
    _Pragma("unroll") for (int _i = 0; _i < 2; ++_i) { \
      __builtin_amdgcn_global_load_lds((const unsigned*)(_kg + ksrc[_i]), (G8_LAS unsigned*)(lds + (buf) * 32768 + _i * 8192 + ldsw), 16, 0, 0); \
      __builtin_amdgcn_global_load_lds((const unsigned*)(_vg + vsrc[_i]), (G8_LAS unsigned*)(lds + (buf) * 32768 + 16384 + _i * 8192 + ldsw), 16, 0, 0); } } while (0)
  __syncthreads();
  KV_ISSUE(jlo, 0);
  if (jlo + 1 <= jhi) KV_ISSUE(jlo + 1, 1);
  asm volatile("s_waitcnt vmcnt(0)" ::: "memory");
  __syncthreads();
  int buf = 0;
  for (int j = jlo; j <= jhi; j += 2) {
    if (j + 2 <= jhi) KV_ISSUE(j + 2, (buf ^ 1) * 2);
    if (j + 3 <= jhi) KV_ISSUE(j + 3, (buf ^ 1) * 2 + 1);
#pragma unroll 1
    for (int t = 0; t < 2; ++t) {
      if (j + t > jhi) break;
      const char* tb = (const char*)(smem + buf * 65536 + t * 32768);
      body(j + t, tb, tb + 16384);
    }
    asm volatile("s_waitcnt vmcnt(0)" ::: "memory");
    __syncthreads();
    buf ^= 1;
  }
#undef KV_ISSUE
}

#define SB0 __builtin_amdgcn_sched_barrier(0)
template <int NKK>
DI void load_kfrags(bf16x8 (&kf)[4][NKK], const char* Kb, int chunk0, int lr, int quad) {
#pragma unroll
  for (int kt = 0; kt < 4; ++kt)
#pragma unroll
    for (int kk = 0; kk < NKK; ++kk)
      kf[kt][kk] = *(const bf16x8*)(Kb + (kt * 16 + lr) * 256 + (((chunk0 + kk * 4 + quad) ^ lr) << 4));
}
template <int NKK>
DI void mma_S(f32x4 (&s)[4], const bf16x8 (&kf)[4][NKK], const bf16x8 (&qf)[NKK]) {
#pragma unroll
  for (int kt = 0; kt < 4; ++kt) {
    s[kt] = zero4();
#pragma unroll
    for (int kk = 0; kk < NKK; ++kk) s[kt] = mfma16(kf[kt][kk], qf[kk], s[kt]);
  }
}
DI bf16x8 load_vfrag(const char* Vb, int s2, int dt, int lr, int quad) {
  return *(const bf16x8*)(Vb + (dt * 16 + lr) * 128 + ((((s2 * 4 + quad) ^ (lr >> 1))) << 4));
}
DI void load_vgroup(bf16x8 (&vf)[8], const char* Vb, int s2, int lr, int quad) {
#pragma unroll
  for (int dt = 0; dt < 8; ++dt) vf[dt] = load_vfrag(Vb, s2, dt, lr, quad);
}
DI void mma_PV(f32x4 (&o)[8], const bf16x8 (&vf)[8], bf16x8 pf) {
#pragma unroll
  for (int dt = 0; dt < 8; ++dt) o[dt] = mfma16(vf[dt], pf, o[dt]);
}
DI void mma_PV2(f32x4 (&o0)[8], f32x4 (&o1)[8], const bf16x8 (&vf)[8], bf16x8 p0, bf16x8 p1) {
#pragma unroll
  for (int dt = 0; dt < 8; ++dt) { o0[dt] = mfma16(vf[dt], p0, o0[dt]); o1[dt] = mfma16(vf[dt], p1, o1[dt]); }
}
DI void ldk4(bf16x8 (&k)[4], const char* Kb, int kt, int lr, int quad) {
#pragma unroll
  for (int kk = 0; kk < 4; ++kk) k[kk] = *(const bf16x8*)(Kb + (kt * 16 + lr) * 256 + (((kk * 4 + quad) ^ lr) << 4));
}
DI f32x4 mma4(const bf16x8 (&k)[4], const bf16x8 (&qf)[4]) {
  f32x4 a = zero4();
  __builtin_amdgcn_s_setprio(1);
#pragma unroll
  for (int kk = 0; kk < 4; ++kk) a = mfma16(k[kk], qf[kk], a);
  __builtin_amdgcn_s_setprio(0);
  return a;
}
DI void ldv4(bf16x8 (&v)[4], const char* Vb, int qtr, int lr, int quad) {
#pragma unroll
  for (int i = 0; i < 4; ++i) v[i] = load_vfrag(Vb, qtr >> 1, 4 * (qtr & 1) + i, lr, quad);
}
DI void nsa_S(f32x4 (&s)[4], const char* Kb, const char* Vb, const bf16x8 (&qf)[4], bf16x8 (&v0)[4], int lr, int quad) {
  bf16x8 k0[4], k1[4], k2[4], k3[4];
  ldk4(k0, Kb, 0, lr, quad); SB0;
  ldk4(k1, Kb, 1, lr, quad); s[0] = mma4(k0, qf); SB0;
  ldk4(k2, Kb, 2, lr, quad); s[1] = mma4(k1, qf); SB0;
  ldk4(k3, Kb, 3, lr, quad); s[2] = mma4(k2, qf); SB0;
  ldv4(v0, Vb, 0, lr, quad); s[3] = mma4(k3, qf); SB0;
}
DI void nsa_PV(f32x4 (&o)[8], const char* Vb, const bf16x8 (&pf)[2], bf16x8 (&v0)[4], int lr, int quad) {
  bf16x8 v1[4], v2[4], v3[4];
  SB0;
  ldv4(v1, Vb, 1, lr, quad);
  __builtin_amdgcn_s_setprio(1);
#pragma unroll
  for (int i = 0; i < 4; ++i) o[i] = mfma16(v0[i], pf[0], o[i]);
  __builtin_amdgcn_s_setprio(0);
  SB0;
  ldv4(v2, Vb, 2, lr, quad);
  __builtin_amdgcn_s_setprio(1);
#pragma unroll
  for (int i = 0; i < 4; ++i) o[4 + i] = mfma16(v1[i], pf[0], o[4 + i]);
  __builtin_amdgcn_s_setprio(0);
  SB0;
  ldv4(v3, Vb, 3, lr, quad);
  __builtin_amdgcn_s_setprio(1);
#pragma unroll
  for (int i = 0; i < 4; ++i) o[i] = mfma16(v2[i], pf[1], o[i]);
  __builtin_amdgcn_s_setprio(0);
  SB0;
  __builtin_amdgcn_s_setprio(1);
#pragma unroll
  for (int i = 0; i < 4; ++i) o[4 + i] = mfma16(v3[i], pf[1], o[4 + i]);
  __builtin_amdgcn_s_setprio(0);
}
DI void ldk2(bf16x8 (&k)[2], const char* Kb, int step, int lr, int quad) {
  const int m = step >> 2, kt = step & 3;
#pragma unroll
  for (int kk = 0; kk < 2; ++kk) k[kk] = *(const bf16x8*)(Kb + (kt * 16 + lr) * 256 + (((m * 8 + kk * 4 + quad) ^ lr) << 4));
}
DI f32x4 mma2(const bf16x8 (&k)[2], const bf16x8 (&qf)[2]) {
  f32x4 a = zero4();
  __builtin_amdgcn_s_setprio(1);
  a = mfma16(k[0], qf[0], a); a = mfma16(k[1], qf[1], a);
  __builtin_amdgcn_s_setprio(0);
  return a;
}
DI void diff_S(f32x4 (&s0)[4], f32x4 (&s1)[4], const char* Kb, const char* Vb, const bf16x8 (&qf0)[2], const bf16x8 (&qf1)[2],
               bf16x8 (&v0)[4], bf16x8 (&v1)[4], int lr, int quad) {
  bf16x8 f0[2], f1[2], f2[2], f3[2], f4[2], f5[2], f6[2], f7[2];
  ldk2(f0, Kb, 0, lr, quad); ldk2(f1, Kb, 1, lr, quad); ldk2(f2, Kb, 2, lr, quad); ldk2(f3, Kb, 3, lr, quad); SB0;
  ldk2(f4, Kb, 4, lr, quad); s0[0] = mma2(f0, qf0); SB0;
  ldk2(f5, Kb, 5, lr, quad); s0[1] = mma2(f1, qf0); SB0;
  ldk2(f6, Kb, 6, lr, quad); s0[2] = mma2(f2, qf0); SB0;
  ldk2(f7, Kb, 7, lr, quad); s0[3] = mma2(f3, qf0); SB0;
  ldv4(v0, Vb, 0, lr, quad); s1[0] = mma2(f4, qf1); s1[1] = mma2(f5, qf1); SB0;
  ldv4(v1, Vb, 1, lr, quad); s1[2] = mma2(f6, qf1); s1[3] = mma2(f7, qf1); SB0;
}
DI void diff_PV(f32x4 (&o0)[8], f32x4 (&o1)[8], const char* Vb, const bf16x8 (&p0)[2], const bf16x8 (&p1)[2], bf16x8 (&v0)[4], bf16x8 (&v1)[4], int lr, int quad) {
  bf16x8 v2[4], v3[4];
  SB0;
  ldv4(v2, Vb, 2, lr, quad);
  __builtin_amdgcn_s_setprio(1);
#pragma unroll
  for (int i = 0; i < 4; ++i) { o0[i] = mfma16(v0[i], p0[0], o0[i]); o1[i] = mfma16(v0[i], p1[0], o1[i]); }
  __builtin_amdgcn_s_setprio(0);
  SB0;
  ldv4(v3, Vb, 3, lr, quad);
  __builtin_amdgcn_s_setprio(1);
#pragma unroll
  for (int i = 0; i < 4; ++i) { o0[4 + i] = mfma16(v1[i], p0[0], o0[4 + i]); o1[4 + i] = mfma16(v1[i], p1[0], o1[4 + i]); }
  __builtin_amdgcn_s_setprio(0);
  SB0;
  __builtin_amdgcn_s_setprio(1);
#pragma unroll
  for (int i = 0; i < 4; ++i) { o0[i] = mfma16(v2[i], p0[1], o0[i]); o1[i] = mfma16(v2[i], p1[1], o1[i]); }
  __builtin_amdgcn_s_setprio(0);
  __builtin_amdgcn_s_setprio(1);
#pragma unroll
  for (int i = 0; i < 4; ++i) { o0[4 + i] = mfma16(v3[i], p0[1], o0[4 + i]); o1[4 + i] = mfma16(v3[i], p1[1], o1[4 + i]); }
  __builtin_amdgcn_s_setprio(0);
}
DI void pack_p(const f32x4 (&s)[4], bf16x8 (&pf)[2]) {
#pragma unroll
  for (int s2 = 0; s2 < 2; ++s2)
    pf[s2] = mk8(pk2(s[2 * s2][0], s[2 * s2][1]), pk2(s[2 * s2][2], s[2 * s2][3]),
                 pk2(s[2 * s2 + 1][0], s[2 * s2 + 1][1]), pk2(s[2 * s2 + 1][2], s[2 * s2 + 1][3]));
}
template <bool MASKED, class MF>
DI void flash_update(f32x4 (&s)[4], float scl, float& mx, float& ls, f32x4 (&o)[8], MF maskfn, bool lane_on) {
  float tmax = -1e30f;
#pragma unroll
  for (int kt = 0; kt < 4; ++kt)
#pragma unroll
    for (int i = 0; i < 4; ++i) {
      if (MASKED) { if (maskfn(kt, i)) s[kt][i] = -1e30f; }
      tmax = fmaxf(tmax, s[kt][i]);
    }
  tmax = rowmax4(tmax);
  if (!lane_on) tmax = -1e30f;
  const float th = 8.f / scl;
  if (__any(tmax > mx + th)) {
    const float mnew = fmaxf(mx, tmax);
    const float alpha = ex2((mx - mnew) * scl);
    ls *= alpha;
#pragma unroll
    for (int dt = 0; dt < 8; ++dt) o[dt] *= alpha;
    mx = mnew;
  }
  const float off = lane_on ? -mx * scl : -1e30f;
  float rs = 0.f;
#pragma unroll
  for (int kt = 0; kt < 4; ++kt)
#pragma unroll
    for (int i = 0; i < 4; ++i) {
      float pv = ex2(fmaf(s[kt][i], scl, off));
      if (MASKED) pv = (s[kt][i] > -1e29f) ? pv : 0.f;
      s[kt][i] = pv; rs += pv;
    }
  ls += rs;
}

DI void ldk2m(bf16x8 (&k)[2], const char* Kb, int m, int kt, int lr, int quad) {
#pragma unroll
  for (int kk = 0; kk < 2; ++kk) k[kk] = *(const bf16x8*)(Kb + (kt * 16 + lr) * 256 + (((m * 8 + kk * 4 + quad) ^ lr) << 4));
}
DI void diff_S2(f32x4 (&s0)[4], f32x4 (&s1)[4], const char* Kb, const char* Vb, int m, const bf16x8 (&q0)[2], const bf16x8 (&q1)[2],
                bf16x8 (&v0)[4], bf16x8 (&v1)[4], int lr, int quad) {
  bf16x8 f0[2], f1[2], f2[2], f3[2];
  ldk2m(f0, Kb, m, 0, lr, quad); ldk2m(f1, Kb, m, 1, lr, quad); SB0;
  ldk2m(f2, Kb, m, 2, lr, quad); s0[0] = mma2(f0, q0); s1[0] = mma2(f0, q1); SB0;
  ldk2m(f3, Kb, m, 3, lr, quad); s0[1] = mma2(f1, q0); s1[1] = mma2(f1, q1); SB0;
  ldv4(v0, Vb, 0, lr, quad); s0[2] = mma2(f2, q0); s1[2] = mma2(f2, q1); SB0;
  ldv4(v1, Vb, 1, lr, quad); s0[3] = mma2(f3, q0); s1[3] = mma2(f3, q1); SB0;
}
DI void diff_item(const Params& p, int b, int h, int qb, float lam, char* smem, int tid) {
  const int lane = tid & 63, wid = tid >> 6, lr = lane & 15, quad = lane >> 4;
  const int m = wid >> 2, qg = wid & 3;
  const int qw = qb * 128 + qg * 32, qp0 = qw + lr, qp1 = qw + 16 + lr;
  f32x4 o0[8], o1[8];
#pragma unroll
  for (int dt = 0; dt < 8; ++dt) { o0[dt] = zero4(); o1[dt] = zero4(); }
  float mx0 = -1e30f, mx1 = -1e30f, ls0 = 0.f, ls1 = 0.f;
  bf16x8 qf0[2], qf1[2];
  {
    const u16* qb0 = p.Qa + (size_t)(b * SQ + qp0) * 1024 + h * 128 + m * 64 + quad * 8;
    const u16* qb1 = p.Qa + (size_t)(b * SQ + qp1) * 1024 + h * 128 + m * 64 + quad * 8;
#pragma unroll
    for (int kk = 0; kk < 2; ++kk) { qf0[kk] = *(const bf16x8*)(qb0 + kk * 32); qf1[kk] = *(const bf16x8*)(qb1 + kk * 32); }
  }
  const u16* kb = p.Ka + (size_t)b * SQ * 1024 + h * 128;
  const u16* vb = p.VaT + (size_t)(b * 8 + h) * 128 * SQ;
  kv_pipeline(0, qb * 2 + 1, kb, 1024, vb, SQ, smem, tid, [&](int j, const char* Kb, const char* Vb) __attribute__((always_inline)) {
    const int key0 = j * 64;
    if (key0 > qw + 31) return;
    const bool diag = key0 + 63 > qw;
    auto mf0 = [&](int kt, int i) __attribute__((always_inline)) { return key0 + kt * 16 + quad * 4 + i > qp0; };
    auto mf1 = [&](int kt, int i) __attribute__((always_inline)) { return key0 + kt * 16 + quad * 4 + i > qp1; };
    f32x4 s0[4], s1[4];
    bf16x8 pf0[2], pf1[2];
    bf16x8 va[4], vb2[4];
    diff_S2(s0, s1, Kb, Vb, m, qf0, qf1, va, vb2, lr, quad);
    if (diag) {
      flash_update<true>(s0, LOG2E, mx0, ls0, o0, mf0, true);
      flash_update<true>(s1, LOG2E, mx1, ls1, o1, mf1, true);
    } else {
      flash_update<false>(s0, LOG2E, mx0, ls0, o0, mf0, true);
      flash_update<false>(s1, LOG2E, mx1, ls1, o1, mf1, true);
    }
    pack_p(s0, pf0);
    pack_p(s1, pf1);
    diff_PV(o0, o1, Vb, pf0, pf1, va, vb2, lr, quad);
  });
  {
    float la = ls0, lb = ls1;
    la += __shfl_xor(la, 16); la += __shfl_xor(la, 32);
    lb += __shfl_xor(lb, 16); lb += __shfl_xor(lb, 32);
    f32x4* X = (f32x4*)smem;
    if (m == 1) {
      const float ca = lam / la, cb = lam / lb;
#pragma unroll
      for (int dt = 0; dt < 8; ++dt) { X[((qg * 2 + 0) * 8 + dt) * 64 + lane] = o0[dt] * ca; X[((qg * 2 + 1) * 8 + dt) * 64 + lane] = o1[dt] * cb; }
    }
    __syncthreads();
    if (m == 0) {
#pragma unroll
      for (int qt = 0; qt < 2; ++qt) {
        const float i1 = 1.f / (qt ? lb : la);
        f32x4 ov[8];
        float ss = 0.f;
#pragma unroll
        for (int dt = 0; dt < 8; ++dt) {
          ov[dt] = (qt ? o1[dt] : o0[dt]) * i1 - X[((qg * 2 + qt) * 8 + dt) * 64 + lane];
          ss += ov[dt][0] * ov[dt][0] + ov[dt][1] * ov[dt][1] + ov[dt][2] * ov[dt][2] + ov[dt][3] * ov[dt][3];
        }
        ss += __shfl_xor(ss, 16); ss += __shfl_xor(ss, 32);
        const float rn = rsqrtf(ss * (1.f / 128.f) + EPSN) * 0.8f;
        const size_t t = (size_t)(b * SQ + (qt ? qp1 : qp0));
#pragma unroll
        for (int dt = 0; dt < 8; ++dt) {
          const int d0 = dt * 16 + quad * 4;
          float4 g = *(const float4*)(p.diff_g + d0);
          uint2 z = *(const uint2*)(p.Za + t * 1024 + h * 128 + d0);
          float v0 = ov[dt][0] * rn * g.x * bflo(z.x), v1 = ov[dt][1] * rn * g.y * bfhi(z.x);
          float v2 = ov[dt][2] * rn * g.z * bflo(z.y), v3 = ov[dt][3] * rn * g.w * bfhi(z.y);
          uint2 w = {pk2(v0, v1), pk2(v2, v3)};
          *(uint2*)(p.H + t * DM + h * 128 + d0) = w;
        }
      }
    }
  }
}

DI void nsa_item(const Params& p, int b, int g, int qb, char* smem, int tid) {
  const int lane = tid & 63, wid = tid >> 6, lr = lane & 15, quad = lane >> 4;
  const int hh = lr & 3, qi = wid * 4 + (lr >> 2), h = g * 4 + hh, bg = b * 2 + g;
  const int q0 = qb * 32, qp = q0 + qi, cur = q0 >> 6;
  float* imp = (float*)(smem + 131072);
  unsigned* sel = (unsigned*)(smem + 131072 + 32 * 132 * 4);
  const float SCL = 0.08838834764831845f * LOG2E;
  bf16x8 qf[4];
#pragma unroll
  for (int kk = 0; kk < 4; ++kk) qf[kk] = *(const bf16x8*)(p.Qb + (size_t)(b * SQ + qp) * 1024 + h * 128 + kk * 32 + quad * 8);
  float gt[3];
#pragma unroll
  for (int br = 0; br < 3; ++br) gt[br] = p.Bg[(size_t)(b * SQ + qp) * 24 + h * 3 + br];
  uint2 oc[8];
  f32x4 o[8];
#pragma unroll
  for (int dt = 0; dt < 8; ++dt) { oc[dt] = make_uint2(0u, 0u); o[dt] = zero4(); }
  __syncthreads();
  for (int i = tid; i < 32 * 132; i += NTHR) imp[i] = 0.f;
  if (tid < 128) sel[tid] = 0u;
  const u16* kcb = p.Kc + (size_t)bg * 512 * 128;
  const u16* vcb = p.VcT + (size_t)bg * 128 * 512;
  const int ncv = q0 / 16 + 1;
  const int nct = (ncv + 63) >> 6;
  const int cmax = (qp - 31) >> 4;
  float mx = -1e30f, ls = 0.f;
  kv_pipeline(0, nct - 1, kcb, 128, vcb, 512, smem, tid, [&](int j, const char* Kb, const char* Vb) __attribute__((always_inline)) {
    f32x4 s[4];
    bf16x8 va[4];
    nsa_S(s, Kb, Vb, qf, va, lr, quad);
    float tmax = -1e30f;
#pragma unroll
    for (int kt = 0; kt < 4; ++kt)
#pragma unroll
      for (int i = 0; i < 4; ++i) {
        int cc = j * 64 + kt * 16 + quad * 4 + i;
        float v = (cc <= cmax) ? s[kt][i] * SCL : -1e30f;
        s[kt][i] = v; tmax = fmaxf(tmax, v);
      }
    tmax = rowmax4(tmax);
    float mnew = fmaxf(mx, tmax), rs = 0.f;
#pragma unroll
    for (int kt = 0; kt < 4; ++kt)
#pragma unroll
      for (int i = 0; i < 4; ++i) { float v = s[kt][i]; rs += (v > -1e29f) ? ex2(v - mnew) : 0.f; }
    ls = ls * ex2(mx - mnew) + rs; mx = mnew;
  });
  float inv;
  {
    float l = ls; l += __shfl_xor(l, 16); l += __shfl_xor(l, 32);
    inv = (l > 0.f) ? 1.f / l : 0.f;
  }
  kv_pipeline(0, nct - 1, kcb, 128, vcb, 512, smem, tid, [&](int j, const char* Kb, const char* Vb) __attribute__((always_inline)) {
    f32x4 s[4];
    bf16x8 va[4];
    nsa_S(s, Kb, Vb, qf, va, lr, quad);
    float* irow = imp + qi * 132;
#pragma unroll
    for (int kt = 0; kt < 4; ++kt) {
      float a = 0.f;
#pragma unroll
      for (int i = 0; i < 4; ++i) {
        int cc = j * 64 + kt * 16 + quad * 4 + i;
        float pv = (cc <= cmax) ? ex2(s[kt][i] * SCL - mx) * inv : 0.f;
        s[kt][i] = pv; a += pv;
      }
      if (a != 0.f) {
        int n1 = j * 16 + kt * 4 + quad;
        atomicAdd(irow + n1, a);
        if (s[kt][3] != 0.f) atomicAdd(irow + n1 + 1, s[kt][3]);
      }
    }
    bf16x8 pf[2];
    pack_p(s, pf);
    nsa_PV(o, Vb, pf, va, lr, quad);
  });
#pragma unroll
  for (int dt = 0; dt < 8; ++dt) { f32x4 t = o[dt] * gt[0]; oc[dt] = make_uint2(pk2(t[0], t[1]), pk2(t[2], t[3])); o[dt] = zero4(); }
  {
    const int q = tid >> 4, sub = tid & 15;
    float v[8];
#pragma unroll
    for (int jj = 0; jj < 8; ++jj) {
      int n = sub + 16 * jj;
      float x = imp[q * 132 + n];
      bool forced = (n == 0) | (n == cur) | (n == cur - 1);
      x = (n <= cur) ? (forced ? 1e4f : x) : -1e30f;
      v[jj] = x; imp[q * 132 + n] = x;
    }
    __syncthreads();
    int rk[8];
#pragma unroll
    for (int jj = 0; jj < 8; ++jj) rk[jj] = 0;
    for (int n2 = 0; n2 <= cur; ++n2) {
      float y = imp[q * 132 + n2];
#pragma unroll
      for (int jj = 0; jj < 8; ++jj) {
        int n = sub + 16 * jj;
        rk[jj] += ((y > v[jj]) | ((y == v[jj]) & (n2 < n))) ? 1 : 0;
      }
    }
#pragma unroll
    for (int jj = 0; jj < 8; ++jj) {
      int n = sub + 16 * jj;
      if (n <= cur && rk[jj] < 16) atomicOr(&sel[q * 4 + (n >> 5)], 1u << (n & 31));
    }
  }
  {
    float mx2 = -1e30f, l2 = 0.f;
    const u16* kb = p.Ks + (size_t)b * SQ * 256 + g * 128;
    const u16* vb = p.VsT + (size_t)bg * 128 * SQ;
    kv_pipeline(0, cur, kb, 256, vb, SQ, smem, tid, [&](int j, const char* Kb, const char* Vb) __attribute__((always_inline)) {
      const bool sb = (sel[qi * 4 + (j >> 5)] >> (j & 31)) & 1u;
      if (!__any(sb)) return;
      f32x4 s[4];
      bf16x8 va[4];
      nsa_S(s, Kb, Vb, qf, va, lr, quad);
      auto mf = [&](int kt, int i) __attribute__((always_inline)) { return j * 64 + kt * 16 + quad * 4 + i > qp; };
      if (j == cur) flash_update<true>(s, SCL, mx2, l2, o, mf, sb);
      else flash_update<false>(s, SCL, mx2, l2, o, mf, sb);
      bf16x8 pf[2];
      pack_p(s, pf);
      nsa_PV(o, Vb, pf, va, lr, quad);
    });
    float l = l2; l += __shfl_xor(l, 16); l += __shfl_xor(l, 32);
    float f = (l > 0.f) ? gt[1] / l : 0.f;
#pragma unroll
    for (int dt = 0; dt < 8; ++dt) {
      f32x4 t = o[dt] * f;
      oc[dt] = make_uint2(pk2(bflo(oc[dt].x) + t[0], bfhi(oc[dt].x) + t[1]), pk2(bflo(oc[dt].y) + t[2], bfhi(oc[dt].y) + t[3]));
      o[dt] = zero4();
    }
  }
  {
    float mx2 = -1e30f, l2 = 0.f;
    const u16* kb = p.Kw + (size_t)b * SQ * 256 + g * 128;
    const u16* vb = p.VwT + (size_t)bg * 128 * SQ;
    int jlo = (q0 - 511) >> 6; if (jlo < 0) jlo = 0;
    kv_pipeline(jlo, cur, kb, 256, vb, SQ, smem, tid, [&](int j, const char* Kb, const char* Vb) __attribute__((always_inline)) {
      f32x4 s[4];
      bf16x8 va[4];
      nsa_S(s, Kb, Vb, qf, va, lr, quad);
      auto mf = [&](int kt, int i) __attribute__((always_inline)) {
        int key = j * 64 + kt * 16 + quad * 4 + i;
        return (key > qp) || (key <= qp - 512);
      };
      if (j * 64 + 63 <= q0 && j * 64 > q0 + 31 - 512) flash_update<false>(s, SCL, mx2, l2, o, mf, true);
      else flash_update<true>(s, SCL, mx2, l2, o, mf, true);
      bf16x8 pf[2];
      pack_p(s, pf);
      nsa_PV(o, Vb, pf, va, lr, quad);
    });
    float l = l2; l += __shfl_xor(l, 16); l += __shfl_xor(l, 32);
    float f = (l > 0.f) ? gt[2] / l : 0.f;
#pragma unroll
    for (int dt = 0; dt < 8; ++dt) o[dt] = o[dt] * f + (f32x4){bflo(oc[dt].x), bfhi(oc[dt].x), bflo(oc[dt].y), bfhi(oc[dt].y)};
  }
  {
    const size_t t = (size_t)(b * SQ + qp);
#pragma unroll
    for (int dt = 0; dt < 8; ++dt) {
      const int d0 = dt * 16 + quad * 4;
      uint2 z = *(const uint2*)(p.Zb + t * 1024 + h * 128 + d0);
      uint2 w = {pk2(o[dt][0] * bflo(z.x), o[dt][1] * bfhi(z.x)), pk2(o[dt][2] * bflo(z.y), o[dt][3] * bfhi(z.y))};
      *(uint2*)(p.H + t * DM + 1024 + h * 128 + d0) = w;
    }
  }
}

DI void phase_diff(const Params& p, char* smem, int tid0) {
  int tid = tid0;
  float s1 = 0.f, s2 = 0.f;
  for (int i = 0; i < 64; ++i) { s1 += p.lq1[i] * p.lk1[i]; s2 += p.lq2[i] * p.lk2[i]; }
  const float lam = expf(s1) - expf(s2) + 0.2f;
  int* s_item = (int*)(smem + SMEM_BYTES - 16);
  for (;;) {
    __syncthreads();
    if (tid == 0) *s_item = atomicAdd(p.ctr, 1);
    __syncthreads();
    int it = *s_item;
    if (it >= 64 + 2048) break;
    asm volatile("" : "+v"(tid));
    if (it < 64) { cmp1_tile(p, it, smem, tid); continue; }
    it -= 64;
    const int r = 63 - (it >> 5), k = it & 31;
    diff_item(p, k >> 3, k & 7, r, lam, smem, tid);
  }
}
DI void phase_nsa(const Params& p, char* smem, int tid0) {
  int tid = tid0;
  int* s_item = (int*)(smem + SMEM_BYTES - 16);
  for (;;) {
    __syncthreads();
    if (tid == 0) *s_item = atomicAdd(p.ctr + 1, 1);
    __syncthreads();
    const int it = *s_item;
    if (it >= 2048) break;
    asm volatile("" : "+v"(tid));
    const int kk = it & 7;
    nsa_item(p, kk >> 1, kk & 1, 255 - (it >> 3), smem, tid);
  }
}

DI void phase_final(const Params& p, int tid) {
  const int lane = tid & 63, wid = tid >> 6;
  for (int it = blockIdx.x; it < TT / 16; it += gridDim.x) {
#pragma unroll 1
    for (int rr = 0; rr < 2; ++rr) {
      int row = it * 16 + wid * 2 + rr;
      float4* xr = (float4*)(p.out + (size_t)row * DM);
      const float4* xin = (const float4*)(p.x + (size_t)row * DM);
      const uint2* yin = (const uint2*)(p.Za + (size_t)row * DM);
      float4 v[8]; float ss = 0;
#pragma unroll
      for (int i = 0; i < 8; ++i) {
        float4 xv = xin[lane + 64 * i]; uint2 yv = yin[lane + 64 * i];
        v[i] = make_float4(xv.x + bflo(yv.x), xv.y + bfhi(yv.x), xv.z + bflo(yv.y), xv.w + bfhi(yv.y));
        ss += v[i].x * v[i].x + v[i].y * v[i].y + v[i].z * v[i].z + v[i].w * v[i].w;
      }
      ss = wave_sum(ss);
      float rs = rsqrtf(ss * (1.f / DM) + EPSN);
      const float4* g4 = (const float4*)p.fin_g;
#pragma unroll
      for (int i = 0; i < 8; ++i) {
        float4 g = g4[lane + 64 * i];
        xr[lane + 64 * i] = make_float4(v[i].x * rs * g.x, v[i].y * rs * g.y, v[i].z * rs * g.z, v[i].w * rs * g.w);
      }
    }
  }
}

DI void grid_bar(int* cnt, int target) {
  __syncthreads();
  if (threadIdx.x == 0) {
    __builtin_amdgcn_fence(__ATOMIC_RELEASE, "agent");
    asm volatile("s_waitcnt vmcnt(0)" ::: "memory");
    __hip_atomic_fetch_add(cnt, 1, __ATOMIC_RELAXED, __HIP_MEMORY_SCOPE_AGENT);
    while (__hip_atomic_load(cnt, __ATOMIC_RELAXED, __HIP_MEMORY_SCOPE_AGENT) < target) __builtin_amdgcn_s_sleep(2);
    __builtin_amdgcn_fence(__ATOMIC_ACQUIRE, "agent");
    asm volatile("s_waitcnt vmcnt(0)" ::: "memory");
  }
  __syncthreads();
}

template <int PH>
DI void run_phase(const Params& p, char* smem, int tid) {
  if (PH == 0) phase_prep(p, smem, tid);
  else if (PH == 1) phase_h(p, tid);
  else if (PH == 2) phase_inproj(p, smem, tid);
  else if (PH == 3) phase_diff(p, smem, tid);
  else if (PH == 4) phase_cmp2(p, smem, tid);
  else if (PH == 5) phase_nsa(p, smem, tid);
  else if (PH == 6) phase_branch(p, smem, tid);
  else if (PH == 7) phase_outproj(p, smem, tid);
  else phase_final(p, tid);
}

#if MULTI
template <int PH>
__global__ __launch_bounds__(NTHR) void phase_kernel(Params p) {
  extern __shared__ __attribute__((aligned(16))) char smem[];
  run_phase<PH>(p, smem, threadIdx.x);
}
#else
__global__ __launch_bounds__(NTHR) void mega_kernel(Params p) {
  extern __shared__ __attribute__((aligned(16))) char smem[];
  cg::grid_group grid = cg::this_grid();
  int* bar = p.ctr + 16;
  const int G = (int)gridDim.x;
  if (blockIdx.x == 0 && threadIdx.x == 0) __hip_atomic_store(bar, 0, __ATOMIC_RELAXED, __HIP_MEMORY_SCOPE_AGENT);
  { int t = threadIdx.x; asm volatile("" : "+v"(t)); run_phase<0>(p, smem, t); } grid.sync();
  { int t = threadIdx.x; asm volatile("" : "+v"(t)); run_phase<1>(p, smem, t); } grid_bar(bar, 1 * G);
  { int t = threadIdx.x; asm volatile("" : "+v"(t)); run_phase<2>(p, smem, t); } grid_bar(bar, 2 * G);
  { int t = threadIdx.x; asm volatile("" : "+v"(t)); run_phase<3>(p, smem, t); } grid_bar(bar, 3 * G);
  { int t = threadIdx.x; asm volatile("" : "+v"(t)); run_phase<4>(p, smem, t); } grid_bar(bar, 4 * G);
  { int t = threadIdx.x; asm volatile("" : "+v"(t)); run_phase<5>(p, smem, t); } grid_bar(bar, 5 * G);
  { int t = threadIdx.x; asm volatile("" : "+v"(t)); run_phase<6>(p, smem, t); } grid_bar(bar, 6 * G);
  { int t = threadIdx.x; asm volatile("" : "+v"(t)); run_phase<7>(p, smem, t); } grid_bar(bar, 7 * G);
  { int t = threadIdx.x; asm volatile("" : "+v"(t)); run_phase<8>(p, smem, t); }
}
#endif

static size_t alignup(size_t v) { return (v + 255) & ~(size_t)255; }

extern "C" void kernel_launch(void* const* d_in, const int* in_sizes, int n_in, void* d_out, int out_size, void* d_ws,
                              size_t ws_size, hipStream_t stream) {
  Params p{};
  const float** f = (const float**)&p;
  for (int i = 0; i < 20; ++i) f[i] = (const float*)d_in[i];
  p.out = (float*)d_out;
  char* w = (char*)d_ws;
  size_t off = 0;
  auto take = [&](size_t bytes) { char* r = w + off; off = alignup(off + bytes); return r; };
  p.WtIn = (u16*)take((size_t)NWP * DM * 2);
  p.WbT = (u16*)take((size_t)DM * DM * 2);
  p.WoT = (u16*)take((size_t)DM * DM * 2);
  p.W1T = (u16*)take((size_t)2 * 256 * 4096 * 2);
  p.W2T = (u16*)take((size_t)2 * 128 * 256 * 2);
  p.H = (u16*)take((size_t)TT * DM * 2);
  p.Qa = (u16*)take((size_t)TT * 1024 * 2);
  p.Ka = (u16*)take((size_t)TT * 1024 * 2);
  p.VaT = (u16*)take((size_t)TT * 1024 * 2);
  p.Za = (u16*)take((size_t)TT * 1024 * 2);
  p.Qb = (u16*)take((size_t)TT * 1024 * 2);
  p.KcR = (u16*)take((size_t)TT * 256 * 2);
  p.VcR = (u16*)take((size_t)TT * 256 * 2);
  p.Ks = (u16*)take((size_t)TT * 256 * 2);
  p.VsT = (u16*)take((size_t)TT * 256 * 2);
  p.Kw = (u16*)take((size_t)TT * 256 * 2);
  p.VwT = (u16*)take((size_t)TT * 256 * 2);
  p.Zb = (u16*)take((size_t)TT * 1024 * 2);
  p.Mg = (u16*)take((size_t)TT * 4096 * 2);
  p.Hc = (u16*)take((size_t)2 * 4096 * 256 * 2);
  p.Kc = (u16*)take((size_t)8 * 512 * 128 * 2);
  p.VcT = (u16*)take((size_t)8 * 128 * 512 * 2);
  p.Bg = (float*)take((size_t)TT * 24 * 4);
  p.mod = (float*)take((size_t)NB * 6144 * 4);
  p.cvec = (float*)take(512 * 4);
  p.tabA = (float2*)take((size_t)SQ * 8 * 8);
  p.tabB = (float2*)take((size_t)SQ * 16 * 8);
  p.ctr = (int*)take(256);
  p.Merged = p.Qa;
  if (off > ws_size) { fprintf(stderr, "workspace too small: need %zu have %zu\n", off, ws_size); return; }

  static int grid_blocks = 0;
#if MULTI
  if (!grid_blocks) {
    hipFuncSetAttribute((const void*)phase_kernel<0>, hipFuncAttributeMaxDynamicSharedMemorySize, SMEM_BYTES);
    hipFuncSetAttribute((const void*)phase_kernel<1>, hipFuncAttributeMaxDynamicSharedMemorySize, SMEM_BYTES);
    hipFuncSetAttribute((const void*)phase_kernel<2>, hipFuncAttributeMaxDynamicSharedMemorySize, SMEM_BYTES);
    hipFuncSetAttribute((const void*)phase_kernel<3>, hipFuncAttributeMaxDynamicSharedMemorySize, SMEM_BYTES);
    hipFuncSetAttribute((const void*)phase_kernel<4>, hipFuncAttributeMaxDynamicSharedMemorySize, SMEM_BYTES);
    hipFuncSetAttribute((const void*)phase_kernel<5>, hipFuncAttributeMaxDynamicSharedMemorySize, SMEM_BYTES);
    hipFuncSetAttribute((const void*)phase_kernel<6>, hipFuncAttributeMaxDynamicSharedMemorySize, SMEM_BYTES);
    hipFuncSetAttribute((const void*)phase_kernel<7>, hipFuncAttributeMaxDynamicSharedMemorySize, SMEM_BYTES);
    hipFuncSetAttribute((const void*)phase_kernel<8>, hipFuncAttributeMaxDynamicSharedMemorySize, SMEM_BYTES);
    grid_blocks = 256;
  }
  phase_kernel<0><<<grid_blocks, NTHR, SMEM_BYTES, stream>>>(p);
  phase_kernel<1><<<grid_blocks, NTHR, SMEM_BYTES, stream>>>(p);
  phase_kernel<2><<<grid_blocks, NTHR, SMEM_BYTES, stream>>>(p);
  phase_kernel<3><<<grid_blocks, NTHR, SMEM_BYTES, stream>>>(p);
  phase_kernel<4><<<grid_blocks, NTHR, SMEM_BYTES, stream>>>(p);
  phase_kernel<5><<<grid_blocks, NTHR, SMEM_BYTES, stream>>>(p);
  phase_kernel<6><<<grid_blocks, NTHR, SMEM_BYTES, stream>>>(p);
  phase_kernel<7><<<grid_blocks, NTHR, SMEM_BYTES, stream>>>(p);
  phase_kernel<8><<<grid_blocks, NTHR, SMEM_BYTES, stream>>>(p);
#else
  if (!grid_blocks) {
    int dev = 0, cus = 0, per_cu = 0;
    hipGetDevice(&dev);
    hipDeviceGetAttribute(&cus, hipDeviceAttributeMultiprocessorCount, dev);
    hipFuncSetAttribute((const void*)mega_kernel, hipFuncAttributeMaxDynamicSharedMemorySize, SMEM_BYTES);
    hipOccupancyMaxActiveBlocksPerMultiprocessor(&per_cu, (const void*)mega_kernel, NTHR, SMEM_BYTES);
    if (per_cu < 1) per_cu = 1;
    grid_blocks = cus * per_cu;
    grid_blocks -= grid_blocks % 64;
    if (grid_blocks < 64) grid_blocks = 64;
  }
  void* args[] = {&p};
  hipError_t e = hipLaunchCooperativeKernel((const void*)mega_kernel, dim3(grid_blocks), dim3(NTHR), args, SMEM_BYTES, stream);
  if (e != hipSuccess) fprintf(stderr, "cooperative launch failed: %s (grid %d)\n", hipGetErrorString(e), grid_blocks);
#endif
}
```
